# Optimizing an MI355X kernel written in HIP

```python
import math
import jax, jax.numpy as jnp
from jax import lax
import numpy as np

D_MODEL = 2048
BATCH = 2
SEQ = 4096
DEPTH = 4
DEC_BATCH = 32
DEC_SEQ = 8
PAST_LEN = 16384
PAGE_SIZE = 128

D_MIX = D_MODEL
CHUNK = 128
W_A = D_MIX // 4
H_A = 4
C_A = W_A // H_A
W_B = D_MIX // 2
HD_B = 64
H_B = W_B // HD_B
KV_B = 4
REP_B = H_B // KV_B
WINDOW = 128
ROPE_DIM = HD_B // 4
ROPE_THETA = 500000.0
W_C = D_MIX - W_A - W_B
GC = 16
G_C = W_C // GC
P_C = 64
D_IN = 3 * W_A + 2 * W_B + 2 * KV_B * HD_B + 2 * W_C
EPS = 1e-5
NEG = -1e30

kernel_name = "hymba_chunkmlp_swa_s5_step"


def rmsnorm(x, g):
    xf = x.astype(jnp.float32)
    y = xf * lax.rsqrt(jnp.mean(xf * xf, axis=-1, keepdims=True) + EPS)
    return (y * g.astype(jnp.float32)).astype(x.dtype)


def rope(x, pos):
    half = ROPE_DIM // 2
    inv = ROPE_THETA ** (-jnp.arange(half, dtype=jnp.float32) * 2.0 / ROPE_DIM)
    ang = pos[:, None] * inv[None, :]
    cos = jnp.cos(ang)[None, :, None, :]
    sin = jnp.sin(ang)[None, :, None, :]
    xf = x.astype(jnp.float32)
    x1, x2, rest = xf[..., :half], xf[..., half:ROPE_DIM], xf[..., ROPE_DIM:]
    out = jnp.concatenate([x1 * cos - x2 * sin, x2 * cos + x1 * sin, rest], axis=-1)
    return out.astype(x.dtype)


def chunk_mlp(u, v, w_s, b_s):
    bsz, L, _ = v.shape
    n = min(L, CHUNK)
    mask = jnp.tril(jnp.ones((n, n), dtype=bool))
    ws = jnp.where(mask[None], w_s[:, :n, :n].astype(jnp.float32), 0.0)
    vc = v.astype(jnp.float32).reshape(bsz, L // n, n, H_A, C_A)
    z = jnp.einsum('hts,bnshc->bnthc', ws, vc)
    z = z + b_s[:, :n].astype(jnp.float32).T[None, None, :, :, None]
    return u.astype(jnp.float32) * z.reshape(bsz, L, W_A)


def attend_with_sinks(qb, kb, vb, mask, sinks):
    s = jnp.einsum('bnqgrd,bnkgd->bngrqk', qb.astype(jnp.float32), kb.astype(jnp.float32)) * (HD_B ** -0.5)
    s = jnp.where(mask[None, :, None, None], s, NEG)
    sink = sinks.astype(jnp.float32).reshape(KV_B, REP_B)[None, None, :, :, None, None]
    m = jnp.maximum(jnp.max(s, axis=-1, keepdims=True), sink)
    p = jnp.exp(s - m)
    w = p / (jnp.sum(p, axis=-1, keepdims=True) + jnp.exp(sink - m))
    return jnp.einsum('bngrqk,bnkgd->bnqgrd', w, vb.astype(jnp.float32))


def swa_prompt(q, k, v, sinks):
    bsz, L = q.shape[:2]
    nb = L // WINDOW
    qb = q.reshape(bsz, nb, WINDOW, KV_B, REP_B, HD_B)
    pad = ((0, 0), (WINDOW, 0), (0, 0), (0, 0))
    kp = jnp.pad(k, pad).reshape(bsz, nb + 1, WINDOW, KV_B, HD_B)
    vp = jnp.pad(v, pad).reshape(bsz, nb + 1, WINDOW, KV_B, HD_B)
    kb = jnp.concatenate([kp[:, :-1], kp[:, 1:]], axis=2)
    vb = jnp.concatenate([vp[:, :-1], vp[:, 1:]], axis=2)
    i = jnp.arange(WINDOW)[None, :, None]
    j = jnp.arange(2 * WINDOW)[None, None, :]
    blk = jnp.arange(nb)[:, None, None]
    diff = i + WINDOW - j
    mask = (diff >= 0) & (diff < WINDOW) & (blk * WINDOW + j - WINDOW >= 0)
    o = attend_with_sinks(qb, kb, vb, mask, sinks)
    return o.reshape(bsz, L, W_B)


def swa_sample(q, k, v, k_past, v_past, sinks):
    bsz, S = q.shape[:2]
    kb = jnp.concatenate([k_past.astype(k.dtype), k], axis=1)[:, None]
    vb = jnp.concatenate([v_past.astype(v.dtype), v], axis=1)[:, None]
    qb = q.reshape(bsz, 1, S, KV_B, REP_B, HD_B)
    i = jnp.arange(S)[:, None]
    j = jnp.arange(WINDOW + S)[None, :]
    diff = i + WINDOW - j
    mask = ((diff >= 0) & (diff < WINDOW))[None]
    o = attend_with_sinks(qb, kb, vb, mask, sinks)
    return o.reshape(bsz, S, W_B)


def s5(u, h0_re, h0_im, a_re, a_im, log_dt, b_re, b_im, c_re, c_im, d_skip, w_glu, b_glu):
    bsz, L, _ = u.shape
    f32 = jnp.float32
    a_re, a_im = a_re.astype(f32), a_im.astype(f32)
    dt = jnp.exp(log_dt.astype(f32))[:, None]
    mag = jnp.exp(a_re * dt)
    ab_re, ab_im = mag * jnp.cos(a_im * dt), mag * jnp.sin(a_im * dt)
    nr, ni = ab_re - 1.0, ab_im
    den = a_re * a_re + a_im * a_im
    f_re = (nr * a_re + ni * a_im) / den
    f_im = (ni * a_re - nr * a_im) / den
    br, bi = b_re.astype(f32), b_im.astype(f32)
    bb_re = f_re[..., None] * br - f_im[..., None] * bi
    bb_im = f_re[..., None] * bi + f_im[..., None] * br
    uf = u.astype(f32)
    ug = uf.reshape(bsz, L, G_C, GC)
    bu_re = jnp.einsum('gpc,blgc->blgp', bb_re, ug)
    bu_im = jnp.einsum('gpc,blgc->blgp', bb_im, ug)
    h0r, h0i = h0_re.astype(f32), h0_im.astype(f32)
    bu_re = bu_re.at[:, 0].add(ab_re * h0r - ab_im * h0i)
    bu_im = bu_im.at[:, 0].add(ab_re * h0i + ab_im * h0r)
    ar_b = jnp.broadcast_to(ab_re, bu_re.shape)
    ai_b = jnp.broadcast_to(ab_im, bu_re.shape)

    def combine(e1, e2):
        a1r, a1i, b1r, b1i = e1
        a2r, a2i, b2r, b2i = e2
        return (a2r * a1r - a2i * a1i,
                a2r * a1i + a2i * a1r,
                a2r * b1r - a2i * b1i + b2r,
                a2r * b1i + a2i * b1r + b2i)

    _, _, h_re, h_im = lax.associative_scan(combine, (ar_b, ai_b, bu_re, bu_im), axis=1)
    y = (jnp.einsum('gcp,blgp->blgc', c_re.astype(f32), h_re)
         - jnp.einsum('gcp,blgp->blgc', c_im.astype(f32), h_im))
    y = y.reshape(bsz, L, W_C) + d_skip.astype(f32) * uf
    y = jax.nn.gelu(y)
    y = y * jax.nn.sigmoid(y @ w_glu.astype(f32) + b_glu.astype(f32))
    return y, h_re[:, -1], h_im[:, -1]


def mixer_layer(x, pos, k_past, v_past, h0_re, h0_im, norm_g, w_in, w_out, w_s, b_s, sinks,
                a_re, a_im, log_dt, b_re, b_im, c_re, c_im, d_skip, w_glu, b_glu):
    bsz, L, _ = x.shape
    h = rmsnorm(x, norm_g)
    z = h @ w_in
    sizes = [W_A, W_A, W_A, W_B, KV_B * HD_B, KV_B * HD_B, W_B, W_C, W_C]
    splits = [int(s) for s in np.cumsum(sizes)[:-1]]
    u_a, v_a, g_a, q, k, v, g_b, u_c, g_c = jnp.split(z, splits, axis=-1)
    q = rope(q.reshape(bsz, L, H_B, HD_B), pos)
    k = rope(k.reshape(bsz, L, KV_B, HD_B), pos)
    v = v.reshape(bsz, L, KV_B, HD_B)
    out_a = chunk_mlp(u_a, v_a, w_s, b_s)
    if k_past is None:
        out_b = swa_prompt(q, k, v, sinks)
        k_rows, v_rows = k[:, -WINDOW:], v[:, -WINDOW:]
        h0_re = jnp.zeros((bsz, G_C, P_C), jnp.float32)
        h0_im = jnp.zeros((bsz, G_C, P_C), jnp.float32)
    else:
        out_b = swa_sample(q, k, v, k_past, v_past, sinks)
        k_rows, v_rows = k, v
    out_c, h_re, h_im = s5(u_c, h0_re, h0_im, a_re, a_im, log_dt, b_re, b_im, c_re, c_im,
                           d_skip, w_glu, b_glu)
    mixed = jnp.concatenate([
        out_a * jax.nn.silu(g_a.astype(jnp.float32)),
        out_b * jax.nn.silu(g_b.astype(jnp.float32)),
        out_c * jax.nn.silu(g_c.astype(jnp.float32))], axis=-1).astype(x.dtype)
    y = x + mixed @ w_out
    return y, k_rows, v_rows, h_re.astype(x.dtype), h_im.astype(x.dtype), v_a


def setup_inputs(seed: int = 0) -> dict:
    key = jax.random.key(seed)
    ks = jax.random.split(key, 24)
    f32 = jnp.float32
    nrm = lambda k, shape, s: jax.random.normal(k, shape, f32) * s
    n_idx = jnp.arange(P_C, dtype=f32)
    return {
        "x_prompt": nrm(ks[0], (BATCH, SEQ, D_MODEL), 1.0),
        "x_sample": nrm(ks[1], (DEC_BATCH, DEC_SEQ, D_MODEL), 1.0),
        "cache_swa_k": nrm(ks[2], (DEPTH, DEC_BATCH, WINDOW, KV_B, HD_B), 1.0),
        "cache_swa_v": nrm(ks[3], (DEPTH, DEC_BATCH, WINDOW, KV_B, HD_B), 1.0),
        "state_ssm_re": nrm(ks[4], (DEPTH, DEC_BATCH, G_C, P_C), 0.5),
        "state_ssm_im": nrm(ks[5], (DEPTH, DEC_BATCH, G_C, P_C), 0.5),
        "norm_g": 1.0 + nrm(ks[6], (DEPTH, D_MODEL), 0.02),
        "final_norm_g": 1.0 + nrm(ks[7], (D_MODEL,), 0.02),
        "w_in": nrm(ks[8], (DEPTH, D_MODEL, D_IN), D_MODEL ** -0.5),
        "w_out": nrm(ks[9], (DEPTH, D_MIX, D_MODEL), D_MIX ** -0.5),
        "chunk_w_s": nrm(ks[10], (DEPTH, H_A, CHUNK, CHUNK), CHUNK ** -0.5),
        "chunk_b_s": 1.0 + nrm(ks[11], (DEPTH, H_A, CHUNK), 0.02),
        "attn_sinks": nrm(ks[12], (DEPTH, H_B), 1.0),
        "ssm_a_re": -0.5 + nrm(ks[13], (DEPTH, G_C, P_C), 0.01),
        "ssm_a_im": math.pi * n_idx + nrm(ks[14], (DEPTH, G_C, P_C), 0.01),
        "ssm_log_dt": jax.random.uniform(ks[15], (DEPTH, G_C), f32, math.log(1e-3), math.log(1e-1)),
        "ssm_b_re": nrm(ks[16], (DEPTH, G_C, P_C, GC), (2.0 * GC) ** -0.5),
        "ssm_b_im": nrm(ks[17], (DEPTH, G_C, P_C, GC), (2.0 * GC) ** -0.5),
        "ssm_c_re": nrm(ks[18], (DEPTH, G_C, GC, P_C), (2.0 * P_C) ** -0.5),
        "ssm_c_im": nrm(ks[19], (DEPTH, G_C, GC, P_C), (2.0 * P_C) ** -0.5),
        "ssm_d": nrm(ks[20], (DEPTH, W_C), 0.5),
        "glu_w": nrm(ks[21], (DEPTH, W_C, W_C), W_C ** -0.5),
        "glu_b": nrm(ks[22], (DEPTH, W_C), 0.01),
    }


def reference(x_prompt, x_sample, cache_swa_k, cache_swa_v, state_ssm_re, state_ssm_im,
              norm_g, final_norm_g, w_in, w_out, chunk_w_s, chunk_b_s, attn_sinks,
              ssm_a_re, ssm_a_im, ssm_log_dt, ssm_b_re, ssm_b_im, ssm_c_re, ssm_c_im,
              ssm_d, glu_w, glu_b):
    pos_p = jnp.arange(SEQ, dtype=jnp.float32)
    pos_s = jnp.arange(DEC_SEQ, dtype=jnp.float32) + PAST_LEN
    xp, xs = x_prompt, x_sample
    kp_l, vp_l, hrp_l, hip_l = [], [], [], []
    ks_l, vs_l, hrs_l, his_l, va_l = [], [], [], [], []
    for l in range(DEPTH):
        wl = (norm_g[l], w_in[l], w_out[l], chunk_w_s[l], chunk_b_s[l], attn_sinks[l],
              ssm_a_re[l], ssm_a_im[l], ssm_log_dt[l], ssm_b_re[l], ssm_b_im[l],
              ssm_c_re[l], ssm_c_im[l], ssm_d[l], glu_w[l], glu_b[l])
        xp, kp, vp, hrp, hip, _ = mixer_layer(xp, pos_p, None, None, None, None, *wl)
        xs, kss, vss, hrs, his, vas = mixer_layer(xs, pos_s, cache_swa_k[l], cache_swa_v[l],
                                                  state_ssm_re[l], state_ssm_im[l], *wl)
        kp_l.append(kp); vp_l.append(vp); hrp_l.append(hrp); hip_l.append(hip)
        ks_l.append(kss); vs_l.append(vss); hrs_l.append(hrs); his_l.append(his); va_l.append(vas)
    y_prompt = rmsnorm(xp, final_norm_g)
    y_sample = rmsnorm(xs, final_norm_g)
    return (y_prompt, y_sample,
            jnp.stack(kp_l), jnp.stack(vp_l), jnp.stack(ks_l), jnp.stack(vs_l),
            jnp.stack(hrp_l), jnp.stack(hip_l), jnp.stack(hrs_l), jnp.stack(his_l),
            jnp.stack(va_l))
```

```cpp
#include <hip/hip_runtime.h>
#include <hip/hip_cooperative_groups.h>
#include <cstdio>
#include <cstdint>
namespace cg = cooperative_groups;

#ifndef N_LAUNCH_MODE
#define N_LAUNCH_MODE 1
#endif

constexpr int DM = 2048, DIN = 5120, MROWS = 8448, MPROMPT = 8192, NLAYER = 4;
constexpr int C_UA = 0, C_VA = 512, C_GA = 1024, C_Q = 1536, C_K = 2560, C_V = 2816, C_GB = 3072, C_UC = 4096, C_GC = 4608;
constexpr size_t OFF_Y = 0, OFF_KP = 17301504, OFF_VP = 17563648, OFF_KS = 17825792, OFF_VS = 18087936,
                 OFF_HRP = 18350080, OFF_HIP = 18366464, OFF_HRS = 18382848, OFF_HIS = 18644992, OFF_VA = 18907136, OUT_TOTAL = 19431424;
constexpr size_t MiB = 1u << 20;
constexpr size_t WS_CTL = 0, CTL_ZERO_BYTES = 1 * MiB, WS_ROWSS = 65536;
constexpr size_t WS_AB = 1 * MiB, WS_AT = WS_AB + 65536, WS_BB = WS_AT + 65536, WS_CC = WS_BB + 524288, WS_ROPE = WS_CC + 524288, WS_WSB = WS_ROPE + 262656 + 1472  ;
constexpr size_t WS_WGT = 4 * MiB, WS_WOT = 6 * MiB, WS_WIT = 38 * MiB, WS_XB = 118 * MiB, WS_XRES = 151 * MiB, WS_Z = 217 * MiB,
                 WS_MIX = 300 * MiB, WS_VT = 333 * MiB, WS_VAT = 337 * MiB, WS_E = 345 * MiB, WS_H0 = 349 * MiB, WS_END = 353 * MiB;
static_assert(WS_WSB + 524288 <= WS_WGT, "tables fit");
static_assert(WS_WSB % 16 == 0, "align");

namespace pg8 {
#define PG8_LAS __attribute__((address_space(3)))
typedef unsigned short bf16_t;
typedef short bf16x8 __attribute__((ext_vector_type(8)));
typedef float f32x4 __attribute__((ext_vector_type(4)));
typedef unsigned u32x4 __attribute__((ext_vector_type(4)));
typedef unsigned u32x2 __attribute__((ext_vector_type(2)));
constexpr int BM = 256, BK = 64, HALF = 128, HTB = HALF * BK * 2  , STAGE_BYTES = 8 * HTB, NXCD = 8, WGM = 8;
__host__ __device__ __forceinline__ int lds_byte(int r, int c) { const int st = (r >> 4) * 2 + (c >> 5), rr = r & 15, cc = c & 31, ob = rr * 64 + cc * 2; return st * 1024 + (ob ^ (((ob >> 9) & 1) << 5)); }
__host__ __device__ __forceinline__ void stage_rc(int b, int& R, int& C) { const int st = b / 1024, sb = b % 1024, swz = sb ^ (((sb >> 9) & 1) << 5); R = (st >> 1) * 16 + swz / 64; C = (st & 1) * 32 + (swz % 64) / 2; }
__host__ __device__ __forceinline__ int perm32(int rho) { const int n = rho >> 4, i = rho & 15; return 8 * (i >> 2) + 4 * n + (i & 3); }

struct Unit { int pm, pn; };
struct Gemm { const bf16_t* A; const bf16_t* Bt; int M, N, K; };

struct StaticOrder {
    int nM, nN, nwg, G, c;
    __host__ __device__ void init(int M, int N, int G_, int c_) { nM = M / BM; nN = N / BM; nwg = nM * nN; G = G_; c = c_; }
    __host__ __device__ bool next(int i, Unit& u) const {
        const long L = (long)i * G + c; if (L >= nwg) return false;
        int wgid = (int)L; { const int q = nwg / NXCD, r = nwg % NXCD, xcd = wgid % NXCD, off = wgid / NXCD; wgid = (xcd < r ? xcd * (q + 1) : r * (q + 1) + (xcd - r) * q) + off; }
        const int nig = WGM * nN, gid = wgid / nig, fm = gid * WGM, gsz = (nM - fm) < WGM ? (nM - fm) : WGM;
        u.pm = fm + ((wgid % nig) % gsz); u.pn = (wgid % nig) / gsz; return true;
    }
    __device__ __forceinline__ void a_ready(const Unit&) const {}
    __device__ __forceinline__ void done(const Unit&) const {}
};

struct SampleOrder {
    int c, G;
    __device__ __forceinline__ bool next(int i, Unit& u) const { if (i != 0 || c < G - 8) return false; u.pm = 32; u.pn = c - (G - 8); return true; }
    __device__ __forceinline__ void a_ready(const Unit&) const {}
    __device__ __forceinline__ void done(const Unit&) const {}
};
typedef __bf16 bf16x2_t __attribute__((ext_vector_type(2)));
typedef float f32x2_t __attribute__((ext_vector_type(2)));
__device__ __forceinline__ unsigned pk2(float lo, float hi) { f32x2_t v = {lo, hi}; bf16x2_t b = __builtin_convertvector(v, bf16x2_t); return __builtin_bit_cast(unsigned, b); }
__device__ __forceinline__ bf16_t f2bf(float f) { return (bf16_t)(pk2(f, 0.f) & 0xffffu); }
__device__ __forceinline__ float bf2f(bf16_t h) { return __uint_as_float(((unsigned)h) << 16); }

struct EpiIn {
    static constexpr bool PERM = true, AFTER_DRAIN = false;
    unsigned char* ws; float* out; int layer;
    __device__ __forceinline__ void operator()(const f32x4 (&acc)[2][2][4][2], const Unit& u, int wr, int wc, int fr_, int fq_) const {
        int lane_ = threadIdx.x & 63; asm volatile("" : "+v"(lane_));
        const int fr = lane_ & 15, fq = lane_ >> 4;
        const int pn = u.pn, pm = u.pm;
        bf16_t* z = (bf16_t*)(ws + WS_Z); const unsigned long long* rowss = (const unsigned long long*)(ws + WS_ROWSS) + layer * MROWS; const float2* rope = (const float2*)(ws + WS_ROPE);
        bf16_t* vT = (bf16_t*)(ws + WS_VT); bf16_t* vaT = (bf16_t*)(ws + WS_VAT);
        const bool is_rope = (pn >= 6 && pn <= 10) && ((wc & 1) == 0);
#pragma unroll
        for (int ai = 0; ai < 2; ++ai)
#pragma unroll
            for (int m = 0; m < 4; ++m) {
                const int r = pm * BM + ai * HALF + wr * 64 + m * 16 + fr;
                const float rs = rsqrtf((float)rowss[r] * (2.3283064365386963e-10f / 2048.0f) + 1e-5f);
                const int pi = (r < 8192) ? (r & 4095) : (4096 + ((r - 8192) & 7));
#pragma unroll
                for (int bj = 0; bj < 2; ++bj) {
                    f32x4 v0 = acc[ai][bj][m][0] * rs, v1 = acc[ai][bj][m][1] * rs;
                    const int c = pn * BM + bj * HALF + wc * 32 + 8 * fq;
                    if (is_rope) {
                        f32x4 p0, p1;
#pragma unroll
                        for (int e = 0; e < 4; ++e) { p0[e] = __shfl_xor(v0[e], 16); p1[e] = __shfl_xor(v1[e], 16); }
                        if (fq < 2) {
                            const float2* cs = rope + (size_t)pi * 8;
                            const float sg = (fq == 0) ? -1.0f : 1.0f;
#pragma unroll
                            for (int e = 0; e < 4; ++e) {
                                const float2 c0 = cs[e], c1 = cs[4 + e];
                                v0[e] = v0[e] * c0.x + sg * p0[e] * c0.y;
                                v1[e] = v1[e] * c1.x + sg * p1[e] * c1.y;
                            }
                        }
                    }
                    u32x4 w; w.x = pk2(v0[0], v0[1]); w.y = pk2(v0[2], v0[3]); w.z = pk2(v1[0], v1[1]); w.w = pk2(v1[2], v1[3]);
                    *(u32x4*)(z + (size_t)r * DIN + c) = w;
                    if (pn == 10 || pn == 11) {
                        const int cc = c - pn * BM;
                        float* o = nullptr;
                        if (pm == 32) o = out + (pn == 10 ? OFF_KS : OFF_VS) + ((size_t)(layer * 256 + (r - 8192))) * 256 + cc;
                        else if ((pm & 15) == 15 && ai == 1) o = out + (pn == 10 ? OFF_KP : OFF_VP) + ((size_t)((layer * 2 + (pm >> 4)) * 128 + ((r & 4095) - 3968))) * 256 + cc;
                        if (o) { *(f32x4*)o = v0; *(f32x4*)(o + 4) = v1; }
                        if (pn == 11 && pm < 32) {
                            const int b = r >> 12, t = r & 4095;
                            bf16_t* vp = vT + ((size_t)(b * 256 + cc)) * 4096 + t;
#pragma unroll
                            for (int e = 0; e < 8; ++e) vp[(size_t)e * 4096] = (bf16_t)((w[e >> 1] >> (16 * (e & 1))) & 0xffffu);
                        }
                    }
                    if (pn == 2 || pn == 3) {
                        const int ch = c - C_VA;
                        if (pm < 32) {
                            bf16_t* vp = vaT + (size_t)ch * 8192 + r;
#pragma unroll
                            for (int e = 0; e < 8; ++e) vp[(size_t)e * 8192] = (bf16_t)((w[e >> 1] >> (16 * (e & 1))) & 0xffffu);
                        } else {
                            float* o = out + OFF_VA + ((size_t)(layer * 256 + (r - 8192))) * 512 + ch;
                            *(f32x4*)o = v0; *(f32x4*)(o + 4) = v1;
                        }
                    }
                }
            }
    }
};

struct EpiOut {
    static constexpr bool PERM = false, AFTER_DRAIN = false;
    const float* xp; const float* xs; unsigned char* ws; int layer;
    __device__ __forceinline__ void operator()(const f32x4 (&acc)[2][2][4][2], const Unit& u, int wr, int wc, int fr_, int fq_) const {
        int lane_ = threadIdx.x & 63; asm volatile("" : "+v"(lane_));
        const int fr = lane_ & 15, fq = lane_ >> 4;
        float* xres = (float*)(ws + WS_XRES); bf16_t* xb = (bf16_t*)(ws + WS_XB); unsigned long long* rowss_next = (unsigned long long*)(ws + WS_ROWSS) + (layer + 1) * MROWS;
#pragma unroll
        for (int ai = 0; ai < 2; ++ai)
#pragma unroll
            for (int m = 0; m < 4; ++m) {
                const int r = u.pm * BM + ai * HALF + wr * 64 + m * 16 + fr;
                const float* xo = (r < 8192) ? (xp + (size_t)r * DM) : (xs + (size_t)(r - 8192) * DM);
                float ss = 0.f;
#pragma unroll
                for (int bj = 0; bj < 2; ++bj)
#pragma unroll
                    for (int n = 0; n < 2; ++n) {
                        const int c = u.pn * BM + bj * HALF + wc * 32 + 16 * n + 4 * fq;
                        const f32x4 o = *(const f32x4*)(xo + c) + acc[ai][bj][m][n];
                        *(f32x4*)(xres + (size_t)r * DM + c) = o;
                        u32x2 w; w.x = pk2(o[0], o[1]); w.y = pk2(o[2], o[3]);
                        *(u32x2*)(xb + (size_t)r * DM + c) = w;
                        ss += (o[0] * o[0] + o[1] * o[1]) + (o[2] * o[2] + o[3] * o[3]);
                    }
                ss += __shfl_xor(ss, 16); ss += __shfl_xor(ss, 32);
                if (fq == 0) atomicAdd(rowss_next + r, (unsigned long long)(ss * 4294967296.0f));
                asm volatile("" ::: "memory");
            }
    }
};

template <class Epi, class Sched, bool ALIGN_EPI = false, bool SP2 = false>
__device__ __forceinline__ void gemm_phase(PG8_LAS unsigned char* lds, const Gemm g, const Sched& S, const Epi& E) {
    int tid_ = threadIdx.x; asm volatile("" : "+v"(tid_));
    const int tid = tid_, wid = __builtin_amdgcn_readfirstlane(tid >> 6), lane = tid & 63, wr = wid >> 2, wc = wid & 3, fr = lane & 15, fq = lane >> 4;
    const int K = g.K, nt = K / BK;
    unsigned voffA[2], voffB[2];
#pragma unroll
    for (int i = 0; i < 2; ++i) { int R, C; stage_rc(tid * 16 + i * 8192, R, C); const int Rb = Epi::PERM ? ((R & ~31) + perm32(R & 31)) : R;
        voffA[i] = (unsigned)(R * K + C) * 2u; voffB[i] = (unsigned)(Rb * K + C) * 2u; }
    const size_t kstep = (size_t)(BK * 2);
    const size_t hstep = (size_t)HALF * K * 2;
    const size_t tstep = 2 * hstep;
    const unsigned ldsw = (unsigned)wid * 1024u;
    const int aoff = lds_byte(wr * 64 + fr, fq * 8), boff = lds_byte(wc * 32 + fr, fq * 8);
#define PG8_SA(b, h) (((b) * 2 + (h)) * HTB)
#define PG8_SB(b, h) ((4 + (b) * 2 + (h)) * HTB)
#define PG8_STAGE(bufoff, gbase, voff) do { _Pragma("unroll") for (int _i = 0; _i < 2; ++_i) \
        __builtin_amdgcn_global_load_lds((const unsigned*)((const char*)(gbase) + (voff)[_i]), (PG8_LAS unsigned*)(lds + (bufoff) + ldsw + _i * 8192), 16, 0, 0); } while (0)
#define PG8_LDA(dst, b, h) do { _Pragma("unroll") for (int m = 0; m < 4; ++m) _Pragma("unroll") for (int k = 0; k < 2; ++k) dst[m][k] = *(const PG8_LAS bf16x8*)(lds + PG8_SA(b, h) + aoff + m * 2048 + k * 1024); } while (0)
#define PG8_LDB(dst, b, h) do { _Pragma("unroll") for (int n = 0; n < 2; ++n) _Pragma("unroll") for (int k = 0; k < 2; ++k) dst[n][k] = *(const PG8_LAS bf16x8*)(lds + PG8_SB(b, h) + boff + n * 2048 + k * 1024); } while (0)
#define PG8_MMA(ai, bj, At, Bt) do { __builtin_amdgcn_s_setprio(1); _Pragma("unroll") for (int m = 0; m < 4; ++m) _Pragma("unroll") for (int n = 0; n < 2; ++n) _Pragma("unroll") for (int k = 0; k < 2; ++k) \
        acc[ai][bj][m][n] = __builtin_amdgcn_mfma_f32_16x16x32_bf16(Bt[n][k], At[m][k], acc[ai][bj][m][n], 0, 0, 0); __builtin_amdgcn_s_setprio(0); } while (0)
#define PG8_WAIT_V(n) asm volatile("s_waitcnt vmcnt(" #n ")" ::: "memory")
#define PG8_WAIT_L(n) asm volatile("s_waitcnt lgkmcnt(" #n ")" ::: "memory")
#define PG8_BAR __builtin_amdgcn_s_barrier()
#define PG8_SCHED __builtin_amdgcn_sched_barrier(0)
    Unit cur, nxt; int ui = 0;
    if (!S.next(0, cur)) return;
    f32x4 acc[2][2][4][2];
#pragma unroll
    for (int a = 0; a < 2; ++a)
#pragma unroll
        for (int b = 0; b < 2; ++b)
#pragma unroll
            for (int m = 0; m < 4; ++m)
#pragma unroll
                for (int n = 0; n < 2; ++n) acc[a][b][m][n] = (f32x4){0.f, 0.f, 0.f, 0.f};
    bf16x8 At[4][2], B0[2][2], B1[2][2];
    const char* cA = (const char*)g.A + (size_t)cur.pm * tstep; const char* cB = (const char*)g.Bt + (size_t)cur.pn * tstep;
    S.a_ready(cur);
    if constexpr (SP2) {
        PG8_STAGE(PG8_SB(0, 0), cB, voffB); PG8_STAGE(PG8_SB(0, 1), cB + hstep, voffB); PG8_STAGE(PG8_SA(0, 0), cA, voffA); PG8_STAGE(PG8_SA(0, 1), cA + hstep, voffA);
        if (wr == 1) PG8_BAR;
        PG8_WAIT_V(2); PG8_BAR;
        PG8_STAGE(PG8_SB(1, 0), cB + kstep, voffB); PG8_STAGE(PG8_SA(1, 0), cA + kstep, voffA); PG8_STAGE(PG8_SB(1, 1), cB + hstep + kstep, voffB);
        PG8_WAIT_V(6); PG8_BAR;
    } else {
        PG8_STAGE(PG8_SB(0, 0), cB, voffB); PG8_STAGE(PG8_SA(0, 0), cA, voffA); PG8_STAGE(PG8_SB(0, 1), cB + hstep, voffB); PG8_STAGE(PG8_SA(0, 1), cA + hstep, voffA);
        if (wr == 1) PG8_BAR;
        PG8_WAIT_V(4); PG8_BAR;
        PG8_STAGE(PG8_SB(1, 0), cB + kstep, voffB); PG8_STAGE(PG8_SA(1, 0), cA + kstep, voffA); PG8_STAGE(PG8_SB(1, 1), cB + hstep + kstep, voffB);
        PG8_WAIT_V(6); PG8_BAR;
    }
    for (;;) {
        const bool has_next = S.next(ui + 1, nxt);
        const char* nA = has_next ? (const char*)g.A + (size_t)nxt.pm * tstep : cA; const char* nB = has_next ? (const char*)g.Bt + (size_t)nxt.pn * tstep : cB;
        for (int t = 0; t < nt; t += 2) {
            const bool last = (t == nt - 2);
            const char* a1 = cA + (size_t)(t + 1) * kstep;
            const char* a2 = last ? nA : cA + (size_t)(t + 2) * kstep; const char* b2 = last ? nB : cB + (size_t)(t + 2) * kstep;
            const char* a3 = a2 + kstep; const char* b3 = b2 + kstep;
            if (last && has_next) S.a_ready(nxt);
            if constexpr (SP2) {
            PG8_LDB(B0, 0, 0); PG8_LDB(B1, 0, 1); PG8_SCHED; PG8_LDA(At, 0, 0); PG8_STAGE(PG8_SA(1, 1), a1 + hstep, voffA);
            PG8_WAIT_V(8); PG8_WAIT_L(0); PG8_BAR; PG8_MMA(0, 0, At, B0); PG8_MMA(0, 1, At, B1); PG8_BAR; PG8_SCHED;
            PG8_LDA(At, 0, 1); PG8_STAGE(PG8_SB(0, 0), b2, voffB); PG8_STAGE(PG8_SB(0, 1), b2 + hstep, voffB); PG8_STAGE(PG8_SA(0, 0), a2, voffA);
            PG8_WAIT_V(8); PG8_WAIT_L(0); PG8_BAR; PG8_MMA(1, 0, At, B0); PG8_MMA(1, 1, At, B1); PG8_BAR; PG8_SCHED;
            PG8_LDB(B0, 1, 0); PG8_LDB(B1, 1, 1); PG8_SCHED; PG8_LDA(At, 1, 0); PG8_STAGE(PG8_SA(0, 1), a2 + hstep, voffA);
            PG8_WAIT_V(8); PG8_WAIT_L(0); PG8_BAR; PG8_MMA(0, 0, At, B0); PG8_MMA(0, 1, At, B1); PG8_BAR; PG8_SCHED;
            PG8_LDA(At, 1, 1); PG8_STAGE(PG8_SB(1, 0), b3, voffB); PG8_STAGE(PG8_SB(1, 1), b3 + hstep, voffB); PG8_STAGE(PG8_SA(1, 0), a3, voffA);
            PG8_WAIT_V(8); PG8_WAIT_L(0); PG8_BAR; PG8_MMA(1, 0, At, B0); PG8_MMA(1, 1, At, B1); PG8_BAR; PG8_SCHED;
            } else {
            PG8_LDB(B0, 0, 0); PG8_SCHED; PG8_LDA(At, 0, 0); PG8_STAGE(PG8_SA(1, 1), a1 + hstep, voffA);
            PG8_WAIT_L(8); PG8_BAR; PG8_WAIT_L(0); PG8_MMA(0, 0, At, B0); PG8_BAR; PG8_SCHED;
            PG8_LDB(B1, 0, 1); PG8_STAGE(PG8_SB(0, 0), b2, voffB);
            PG8_BAR; PG8_WAIT_L(0); PG8_MMA(0, 1, At, B1); PG8_BAR;
            PG8_LDA(At, 0, 1); PG8_STAGE(PG8_SA(0, 0), a2, voffA);
            PG8_BAR; PG8_WAIT_L(0); PG8_MMA(1, 0, At, B0); PG8_BAR; PG8_SCHED;
            PG8_STAGE(PG8_SB(0, 1), b2 + hstep, voffB);
            PG8_WAIT_V(6); PG8_BAR; PG8_MMA(1, 1, At, B1); PG8_BAR;
            PG8_LDB(B0, 1, 0); PG8_SCHED; PG8_LDA(At, 1, 0); PG8_STAGE(PG8_SA(0, 1), a2 + hstep, voffA);
            PG8_WAIT_L(8); PG8_BAR; PG8_WAIT_L(0); PG8_MMA(0, 0, At, B0); PG8_BAR; PG8_SCHED;
            PG8_LDB(B1, 1, 1); PG8_STAGE(PG8_SB(1, 0), b3, voffB);
            PG8_BAR; PG8_WAIT_L(0); PG8_MMA(0, 1, At, B1); PG8_BAR;
            PG8_LDA(At, 1, 1); PG8_STAGE(PG8_SA(1, 0), a3, voffA);
            PG8_BAR; PG8_WAIT_L(0); PG8_MMA(1, 0, At, B0); PG8_BAR; PG8_SCHED;
            PG8_STAGE(PG8_SB(1, 1), b3 + hstep, voffB);
            PG8_WAIT_V(6); PG8_BAR; PG8_MMA(1, 1, At, B1); PG8_BAR;
            }
        }
        if constexpr (ALIGN_EPI) { if (wr == 0) PG8_BAR; }
        if constexpr (!Epi::AFTER_DRAIN) { E(acc, cur, wr, wc, fr, fq); S.done(cur); }
        if (!has_next) break;
#pragma unroll
        for (int a = 0; a < 2; ++a)
#pragma unroll
            for (int b = 0; b < 2; ++b)
#pragma unroll
                for (int m = 0; m < 4; ++m)
#pragma unroll
                    for (int n = 0; n < 2; ++n) acc[a][b][m][n] = (f32x4){0.f, 0.f, 0.f, 0.f};
        cur = nxt; cA = nA; cB = nB; ++ui;
        if constexpr (ALIGN_EPI) { if (wr == 1) PG8_BAR; }
    }
    PG8_WAIT_V(0);
    if constexpr (!ALIGN_EPI) { if (wr == 0) PG8_BAR; }
    PG8_BAR;
    if constexpr (Epi::AFTER_DRAIN) { E.fused(acc, cur, wr, wc, fr, fq, lds, wid, lane); S.done(cur); }
#undef PG8_SA
#undef PG8_SB
#undef PG8_STAGE
#undef PG8_LDA
#undef PG8_LDB
#undef PG8_MMA
#undef PG8_WAIT_V
#undef PG8_WAIT_L
#undef PG8_BAR
#undef PG8_SCHED
}
}

using pg8::bf16_t; using pg8::bf16x8; using pg8::f32x4; using pg8::u32x4; using pg8::u32x2; using pg8::pk2; using pg8::f2bf; using pg8::bf2f;
#define LAS __attribute__((address_space(3)))
typedef short s16x4 __attribute__((ext_vector_type(4)));
typedef float f32x16 __attribute__((ext_vector_type(16)));
#define MFMA32(a, b, c) __builtin_amdgcn_mfma_f32_32x32x16_bf16((a), (b), (c), 0, 0, 0)
#define MFMA16(a, b, c) __builtin_amdgcn_mfma_f32_16x16x32_bf16((a), (b), (c), 0, 0, 0)
#define LDS_FENCE() asm volatile("s_waitcnt lgkmcnt(0)" ::: "memory")
#define DI __device__ __forceinline__
constexpr int NWAVES = 8, NTHREADS = 512;
constexpr int LDS_BYTES = 147456;
constexpr int WSCR = 8448;
constexpr int YG_OFF = NWAVES * WSCR;
constexpr int YG_LD = 520;

DI int crow(int reg, int h) { return (reg & 3) + 8 * (reg >> 2) + 4 * h; }
DI float sigmoidf_(float x) { return 1.0f / (1.0f + __expf(-x)); }
DI float siluf_(float x) { return x * sigmoidf_(x); }
DI float gelu_tanh(float y) { const float t = 0.7978845608028654f * (y + 0.044715f * y * y * y); const float th = 1.0f - 2.0f / (__expf(2.0f * t) + 1.0f); return 0.5f * y * (1.0f + th); }
DI float wave_sum(float v) {
#pragma unroll
    for (int o = 1; o < 64; o <<= 1) v += __shfl_xor(v, o);
    return v;
}
DI float wave_max(float v) {
#pragma unroll
    for (int o = 1; o < 64; o <<= 1) v = fmaxf(v, __shfl_xor(v, o));
    return v;
}
DI void sincos_d(double ang, float& s, float& c) {
    const double TWO_PI = 6.283185307179586476925, INV_TWO_PI = 0.15915494309189533576888;
    const double k = rint(ang * INV_TWO_PI);
    const double r = ang - k * TWO_PI, r2 = r * r;
    double ss = 1.0, cc = 1.0;
#pragma unroll
    for (int n = 15; n >= 1; --n) { ss = 1.0 - ss * r2 * (1.0 / ((2.0 * n) * (2.0 * n + 1.0))); cc = 1.0 - cc * r2 * (1.0 / ((2.0 * n - 1.0) * (2.0 * n))); }
    s = (float)(r * ss); c = (float)cc;
}

constexpr int PTR_OFF = 140 * 1024, XB_LDS_OFF = 140 * 1024 + 512;
constexpr size_t WS_XBAR = 512 * 1024;
struct Ctx { unsigned char* ws; float* out; LAS unsigned char* lds; int lane, wave, gw, ngw; };
#define GAS __attribute__((address_space(1)))
DI const GAS float* INP(const Ctx& X, int i) { const volatile LAS unsigned* p = (const volatile LAS unsigned*)(X.lds + PTR_OFF + 8 * i);
    const unsigned lo = __builtin_amdgcn_readfirstlane(p[0]), hi = __builtin_amdgcn_readfirstlane(p[1]); return (const GAS float*)(((unsigned long long)hi << 32) | lo); }
#define W_ROWSS(X) ((unsigned long long*)((X).ws + WS_ROWSS))
#define W_AB(X)    ((float2*)((X).ws + WS_AB))
#define W_AT(X)    ((float2*)((X).ws + WS_AT))
#define W_BB(X)    ((bf16_t*)((X).ws + WS_BB))
#define W_CC(X)    ((bf16_t*)((X).ws + WS_CC))
#define W_ROPE(X)  ((float2*)((X).ws + WS_ROPE))
#define W_WSB(X)   ((bf16_t*)((X).ws + WS_WSB))
#define W_WGT(X)   ((bf16_t*)((X).ws + WS_WGT))
#define W_WOT(X)   ((bf16_t*)((X).ws + WS_WOT))
#define W_WIT(X)   ((bf16_t*)((X).ws + WS_WIT))
#define W_XB(X)    ((bf16_t*)((X).ws + WS_XB))
#define W_XRES(X)  ((float*)((X).ws + WS_XRES))
#define W_Z(X)     ((bf16_t*)((X).ws + WS_Z))
#define W_MIX(X)   ((bf16_t*)((X).ws + WS_MIX))
#define W_VT(X)    ((bf16_t*)((X).ws + WS_VT))
#define W_VAT(X)   ((bf16_t*)((X).ws + WS_VAT))
#define W_E(X)     ((float2*)((X).ws + WS_E))
#define W_H0(X)    ((float2*)((X).ws + WS_H0))
enum { I_XP = 0, I_XS, I_CK, I_CV, I_SRE, I_SIM, I_NG, I_FG, I_WIN, I_WOUT, I_CW, I_CB, I_SINK, I_ARE, I_AIM, I_LDT, I_BRE, I_BIM, I_CRE, I_CIM, I_DSK, I_GW, I_GB };

DI void p0_transpose_item(const GAS float* W, const GAS float* gk, int K, int N, bf16_t* WT, LAS float* scr, int item, int lane) {
    const int nblk = N / 32, kb = item / nblk, nb = item % nblk, k0 = 64 * kb, n0 = 32 * nb;
    const int r8 = lane >> 3, c4 = (lane & 7) * 4;
#pragma unroll
    for (int i = 0; i < 8; ++i) { const int kk = 8 * i + r8; f32x4 v = *(const GAS f32x4*)(W + (size_t)(k0 + kk) * N + n0 + c4); if (gk) v = v * gk[k0 + kk];
        LAS float* d = scr + kk * 33 + c4; d[0] = v[0]; d[1] = v[1]; d[2] = v[2]; d[3] = v[3]; }
    LDS_FENCE();
    const int c = lane & 7;
#pragma unroll
    for (int j = 0; j < 4; ++j) { const int n = (lane >> 3) + 8 * j; const LAS float* s = scr + (8 * c) * 33 + n;
        u32x4 o; o.x = pk2(s[0 * 33], s[1 * 33]); o.y = pk2(s[2 * 33], s[3 * 33]); o.z = pk2(s[4 * 33], s[5 * 33]); o.w = pk2(s[6 * 33], s[7 * 33]);
        *(u32x4*)(WT + (size_t)(n0 + n) * K + k0 + 8 * c) = o; }
    LDS_FENCE();
}

DI void convert_layer_weights(const Ctx& X, int l, int w_id, int n_w) {
    LAS float* scr = (LAS float*)(X.lds + X.wave * WSCR);
    constexpr int I_IN = (DM / 64) * (DIN / 32), I_OUT = (DM / 64) * (DM / 32), I_G = (512 / 64) * (512 / 32), I_L = I_IN + I_OUT + I_G;
    const GAS float* w_in = INP(X, I_WIN); const GAS float* w_out = INP(X, I_WOUT); const GAS float* glu_w = INP(X, I_GW); const GAS float* norm_g = INP(X, I_NG);
    for (int it = w_id; it < I_L; it += n_w) {
        int r = it;
        if (r < I_IN) { p0_transpose_item(w_in + (size_t)l * DM * DIN, norm_g + l * DM, DM, DIN, W_WIT(X) + (size_t)l * DIN * DM, scr, r, X.lane); continue; } r -= I_IN;
        if (r < I_OUT) { p0_transpose_item(w_out + (size_t)l * DM * DM, nullptr, DM, DM, W_WOT(X) + (size_t)l * DM * DM, scr, r, X.lane); continue; } r -= I_OUT;
        p0_transpose_item(glu_w + (size_t)l * 512 * 512, nullptr, 512, 512, W_WGT(X) + (size_t)l * 512 * 512, scr, r, X.lane);
    }
}

DI void phase_prologue(const Ctx& X) {
    convert_layer_weights(X, 0, X.gw, X.ngw);
    if (gridDim.x < 16) { for (int l = 1; l < NLAYER; ++l) convert_layer_weights(X, l, X.gw, X.ngw); }
    { const GAS float* x_prompt = INP(X, I_XP); const GAS float* x_sample = INP(X, I_XS);
    for (int m = X.gw; m < MROWS; m += X.ngw) {
        const GAS float* xr = (m < 8192) ? (x_prompt + (size_t)m * DM) : (x_sample + (size_t)(m - 8192) * DM);
        float ss = 0.f;
#pragma unroll
        for (int j = 0; j < 8; ++j) { const f32x4 v = *(const GAS f32x4*)(xr + 4 * X.lane + 256 * j); ss += (v[0] * v[0] + v[1] * v[1]) + (v[2] * v[2] + v[3] * v[3]);
            u32x2 w; w.x = pk2(v[0], v[1]); w.y = pk2(v[2], v[3]); *(u32x2*)(W_XB(X) + (size_t)m * DM + 4 * X.lane + 256 * j) = w; }
        ss = wave_sum(ss);
        if (X.lane == 0) W_ROWSS(X)[m] = (unsigned long long)(ss * 4294967296.0f);
    } }
    const int gt = X.gw * 64 + X.lane, ngt = X.ngw * 64;
    { const GAS float* log_dt = INP(X, I_LDT); const GAS float* a_re = INP(X, I_ARE); const GAS float* a_im = INP(X, I_AIM); const GAS float* b_re = INP(X, I_BRE); const GAS float* b_im = INP(X, I_BIM);
      const GAS float* c_re = INP(X, I_CRE); const GAS float* c_im = INP(X, I_CIM);
    for (int i = gt; i < NLAYER * 32 * 64; i += ngt) {
        const int lg = i >> 6, p = i & 63;
        const float dt = expf(log_dt[lg]); const float ar = a_re[i], ai = a_im[i];
        float sn, cs; sincos_d((double)ai * (double)dt, sn, cs);
        const float mag = expf(ar * dt); const float abr = mag * cs, abi = mag * sn;
        W_AB(X)[i] = make_float2(abr, abi);
        float sn32, cs32; sincos_d((double)ai * (double)dt * 32.0, sn32, cs32);
        const float mag32 = expf(ar * dt * 32.0f);
        W_AT(X)[i] = make_float2(mag32 * cs32, mag32 * sn32);
        const float nr = abr - 1.0f, ni = abi, den = ar * ar + ai * ai;
        const float f_re = (nr * ar + ni * ai) / den, f_im = (ni * ar - nr * ai) / den;
        unsigned wr[8], wi[8];
#pragma unroll
        for (int c2 = 0; c2 < 8; ++c2) {
            const float br0 = b_re[(size_t)i * 16 + 2 * c2], bi0 = b_im[(size_t)i * 16 + 2 * c2], br1 = b_re[(size_t)i * 16 + 2 * c2 + 1], bi1 = b_im[(size_t)i * 16 + 2 * c2 + 1];
            wr[c2] = pk2(f_re * br0 - f_im * bi0, f_re * br1 - f_im * bi1);
            wi[c2] = pk2(f_re * bi0 + f_im * br0, f_re * bi1 + f_im * br1);
        }
        u32x4* rowr = (u32x4*)(W_BB(X) + ((size_t)lg * 128 + p) * 16); u32x4* rowi = (u32x4*)(W_BB(X) + ((size_t)lg * 128 + 64 + p) * 16);
        rowr[0] = (u32x4){wr[0], wr[1], wr[2], wr[3]}; rowr[1] = (u32x4){wr[4], wr[5], wr[6], wr[7]};
        rowi[0] = (u32x4){wi[0], wi[1], wi[2], wi[3]}; rowi[1] = (u32x4){wi[4], wi[5], wi[6], wi[7]};
    }
    for (int j = gt; j < NLAYER * 32 * 16 * 16; j += ngt) {
        const int kc = j & 15, lc = j >> 4, k0 = 8 * kc;
        const GAS float* src = (k0 < 64) ? (c_re + (size_t)lc * 64 + k0) : (c_im + (size_t)lc * 64 + (k0 - 64));
        const float sg = (k0 < 64) ? 1.0f : -1.0f;
        const f32x4 a0 = *(const GAS f32x4*)src, a1 = *(const GAS f32x4*)(src + 4);
        u32x4 w; w.x = pk2(sg * a0[0], sg * a0[1]); w.y = pk2(sg * a0[2], sg * a0[3]); w.z = pk2(sg * a1[0], sg * a1[1]); w.w = pk2(sg * a1[2], sg * a1[3]);
        *(u32x4*)(W_CC(X) + (size_t)lc * 128 + k0) = w;
    } }
    { const GAS float* chunk_w = INP(X, I_CW);
    for (int j = gt; j < NLAYER * 4 * 128 * 16; j += ngt) {
        const int t = (j >> 4) & 127, s0 = (j & 15) * 8;
        const f32x4 a0 = *(const GAS f32x4*)(chunk_w + (size_t)j * 8), a1 = *(const GAS f32x4*)(chunk_w + (size_t)j * 8 + 4);
        float v[8] = {a0[0], a0[1], a0[2], a0[3], a1[0], a1[1], a1[2], a1[3]};
#pragma unroll
        for (int e = 0; e < 8; ++e) v[e] = (s0 + e <= t) ? v[e] : 0.0f;
        u32x4 w; w.x = pk2(v[0], v[1]); w.y = pk2(v[2], v[3]); w.z = pk2(v[4], v[5]); w.w = pk2(v[6], v[7]);
        *(u32x4*)(W_WSB(X) + (size_t)j * 8) = w;
    } }
    for (int i = gt; i < 4104 * 8; i += ngt) {
        const int pi = i >> 3, j = i & 7;
        const double inv[8] = {1.0, 0.19392274474868576, 0.03760603093086393, 0.007292664737217109, 0.001414213562373095, 0.0002742481756762073, 5.318295896944988e-05, 1.031338537721246e-05};
        double iv = inv[0];
#pragma unroll
        for (int q = 1; q < 8; ++q) iv = (j == q) ? inv[q] : iv;
        const double pos = (pi < 4096) ? (double)pi : (double)(16384 + (pi - 4096));
        float sn, cs; sincos_d(pos * iv, sn, cs);
        W_ROPE(X)[i] = make_float2(cs, sn);
    }
}

DI float2 ld_e(const float2* p) { const unsigned long long v = __hip_atomic_load((const unsigned long long*)p, __ATOMIC_RELAXED, __HIP_MEMORY_SCOPE_SYSTEM); float2 r; r.x = __uint_as_float((unsigned)v); r.y = __uint_as_float((unsigned)(v >> 32)); return r; }
template <bool PASS_C>
DI void s5_wave_unit(const Ctx& X, int layer, int u, int slot, LAS float* bu, LAS bf16_t* yg) {
    const int lane = X.lane, r31 = lane & 31, h = lane >> 5;
    const int R0 = 32 * u; const bool samp = (u >= 256);
    const int b = u >> 7, chn = u & 127;
    const GAS float* st_re = INP(X, I_SRE); const GAS float* st_im = INP(X, I_SIM); const GAS float* dskip = INP(X, I_DSK);
    for (int gi = 0; gi < 4; ++gi) {
        const int g = 4 * slot + gi, lg = layer * 32 + g;
        const float2 ab = W_AB(X)[lg * 64 + lane];
        float hr = 0.f, hi = 0.f;
        if (PASS_C && !samp) { const float2 h0 = W_H0(X)[((size_t)(b * 128 + chn) * 32 + g) * 64 + lane]; hr = h0.x; hi = h0.y; }
        bf16x8 ua = *(const bf16x8*)(W_Z(X) + (size_t)(R0 + r31) * DIN + C_UC + 16 * g + 8 * h);
        bf16x8 bbf[4];
#pragma unroll
        for (int nt = 0; nt < 4; ++nt) bbf[nt] = *(const bf16x8*)(W_BB(X) + ((size_t)lg * 128 + 32 * nt + r31) * 16 + 8 * h);
        f32x16 acc[4];
#pragma unroll
        for (int nt = 0; nt < 4; ++nt) {
            f32x16 zz;
#pragma unroll
            for (int i = 0; i < 16; ++i) zz[i] = 0.f;
            asm volatile("" : "+v"(zz));
            acc[nt] = MFMA32(ua, bbf[nt], zz);
        }
        __builtin_amdgcn_sched_barrier(0);
        asm volatile("s_nop 15\n\ts_nop 15\n\ts_nop 15\n\ts_nop 15\n\ts_nop 15\n\ts_nop 15\n\ts_nop 15\n\ts_nop 15"
                     : "+v"(ua), "+v"(bbf[0]), "+v"(bbf[1]), "+v"(bbf[2]), "+v"(bbf[3]), "+v"(acc[0]), "+v"(acc[1]), "+v"(acc[2]), "+v"(acc[3]) :: "memory");
        __builtin_amdgcn_sched_barrier(0);
        bf16x8 cfrag[4];
        if (PASS_C) {
#pragma unroll
            for (int kk = 0; kk < 4; ++kk) cfrag[kk] = *(const bf16x8*)(W_CC(X) + ((size_t)lg * 16 + (lane & 15)) * 128 + 32 * kk + 8 * (lane >> 4));
        }
        const float dsk = PASS_C ? dskip[layer * 512 + 16 * g + (lane & 15)] : 0.f;
#pragma unroll
        for (int half = 0; half < 2; ++half) {
#pragma unroll
            for (int nt = 0; nt < 4; ++nt)
#pragma unroll
                for (int rr = 0; rr < 8; ++rr) bu[((rr & 3) + 8 * (rr >> 2) + 4 * h) * 132 + 32 * nt + r31] = acc[nt][8 * half + rr];
            LDS_FENCE();
            for (int tl = 0; tl < 16; ++tl) {
                const int t = 16 * half + tl;
                if (samp && (t & 7) == 0) { const size_t si = ((size_t)(layer * 32 + ((R0 - 8192 + t) >> 3)) * 32 + g) * 64 + lane; hr = st_re[si]; hi = st_im[si]; }
                const float br = bu[tl * 132 + lane], bi = bu[tl * 132 + 64 + lane];
                const float nr = ab.x * hr - ab.y * hi + br, ni = ab.x * hi + ab.y * hr + bi; hr = nr; hi = ni;
                if (PASS_C) {
                    LDS_FENCE();
                    LAS bf16_t* hs = (LAS bf16_t*)(bu + tl * 132); hs[lane] = f2bf(hr); hs[64 + lane] = f2bf(hi);
                    if (samp && (t & 7) == 7) { const size_t so = ((size_t)(layer * 32 + ((R0 - 8192 + t) >> 3)) * 32 + g) * 64 + lane; X.out[OFF_HRS + so] = hr; X.out[OFF_HIS + so] = hi; }
                }
            }
            LDS_FENCE();
            if (PASS_C) {
                f32x4 d = {0.f, 0.f, 0.f, 0.f}; asm volatile("" : "+v"(d));
#pragma unroll
                for (int kk = 0; kk < 4; ++kk) { const bf16x8 a = *(const LAS bf16x8*)((const LAS unsigned char*)bu + (lane & 15) * 528 + (32 * kk + 8 * (lane >> 4)) * 2); d = MFMA16(a, cfrag[kk], d); }
                const int ch = 16 * g + (lane & 15);
#pragma unroll
                for (int reg = 0; reg < 4; ++reg) { const int t = 16 * half + 4 * (lane >> 4) + reg; const float uval = bf2f(W_Z(X)[(size_t)(R0 + t) * DIN + C_UC + ch]);
                    yg[t * YG_LD + ch] = f2bf(gelu_tanh(d[reg] + dsk * uval)); }
                LDS_FENCE();
            }
        }
        if (!PASS_C) { W_E(X)[((size_t)(b * 128 + chn) * 32 + g) * 64 + lane] = make_float2(hr, hi); }
        else if (!samp && chn == 127) { const size_t so = ((size_t)(layer * 2 + b) * 32 + g) * 64 + lane; X.out[OFF_HRP + so] = hr; X.out[OFF_HIP + so] = hi; }
    }
}

DI void phase_s5c(const Ctx& X, int layer, int u_first, int u_end) {
    LAS float* bu = (LAS float*)(X.lds + X.wave * WSCR);
    LAS bf16_t* yg = (LAS bf16_t*)(X.lds + YG_OFF);
    const int lane = X.lane, r31 = lane & 31, h = lane >> 5;
    const GAS float* glu_b = INP(X, I_GB);
    for (int u = u_first; u < u_end; u += gridDim.x) {
        s5_wave_unit<true>(X, layer, u, X.wave, bu, yg);
        LDS_FENCE(); __syncthreads();
        f32x16 ga[2];
#pragma unroll
        for (int nt = 0; nt < 2; ++nt)
#pragma unroll
            for (int i = 0; i < 16; ++i) ga[nt][i] = 0.f;
        asm volatile("" : "+v"(ga[0]), "+v"(ga[1]));
        const bf16_t* wg = W_WGT(X) + ((size_t)layer * 512 + 64 * X.wave + r31) * 512 + 8 * h;
#pragma unroll 4
        for (int ks = 0; ks < 32; ++ks) {
            const bf16x8 a = *(const LAS bf16x8*)(yg + r31 * YG_LD + 16 * ks + 8 * h);
#pragma unroll
            for (int nt = 0; nt < 2; ++nt) { const bf16x8 bfrag = *(const bf16x8*)(wg + (size_t)nt * 32 * 512 + 16 * ks); ga[nt] = MFMA32(a, bfrag, ga[nt]); }
        }
        const int R0 = 32 * u;
#pragma unroll
        for (int nt = 0; nt < 2; ++nt) {
            const int n = 64 * X.wave + 32 * nt + r31; const float bg = glu_b[layer * 512 + n];
#pragma unroll
            for (int reg = 0; reg < 16; ++reg) { const int t = crow(reg, h); const size_t row = (size_t)(R0 + t);
                const float gate = sigmoidf_(ga[nt][reg] + bg); const float yv = bf2f(yg[t * YG_LD + n]); const float gc = bf2f(W_Z(X)[row * DIN + C_GC + n]);
                W_MIX(X)[row * DM + 1536 + n] = f2bf(yv * gate * siluf_(gc)); }
        }
        LDS_FENCE(); __syncthreads();
    }
}

DI void attn_item(const Ctx& X, int layer, int it) {
    const int lane = X.lane, r31 = lane & 31, h = lane >> 5;
    const int qt = it & 3, rr = (it >> 2) & 3, g = (it >> 4) & 3, blk = (it >> 6) & 31, b = it >> 11;
    const int head = 4 * g + rr, q0 = blk * 128 + 32 * qt, kbase = q0 - 128;
    const size_t rowb = (size_t)b * 4096;
    bf16x8 qf[4];
#pragma unroll
    for (int ks = 0; ks < 4; ++ks) qf[ks] = *(const bf16x8*)(W_Z(X) + (rowb + q0 + r31) * DIN + C_Q + 64 * head + 16 * ks + 8 * h);
    f32x16 S[5];
#pragma unroll
    for (int kb = 0; kb < 2; ++kb) {
        bf16x8 kf[3][4];
#pragma unroll
        for (int kk = 0; kk < 3; ++kk) { const int kt = 3 * kb + kk; if (kt < 5) {
            int tk = kbase + 32 * kt + r31; tk = tk < 0 ? 0 : tk;
            const bf16_t* kp = W_Z(X) + (rowb + tk) * DIN + C_K + 64 * g + 8 * h;
#pragma unroll
            for (int ks = 0; ks < 4; ++ks) kf[kk][ks] = *(const bf16x8*)(kp + 16 * ks); } }
#pragma unroll
        for (int kk = 0; kk < 3; ++kk) { const int kt = 3 * kb + kk; if (kt < 5) {
            f32x16 s;
#pragma unroll
            for (int i = 0; i < 16; ++i) s[i] = 0.f;
            asm volatile("" : "+v"(s));
#pragma unroll
            for (int ks = 0; ks < 4; ++ks) s = MFMA32(kf[kk][ks], qf[ks], s);
            S[kt] = s; } }
        __builtin_amdgcn_sched_barrier(0);
        asm volatile("s_nop 15\n\ts_nop 15\n\ts_nop 15\n\ts_nop 15\n\ts_nop 15\n\ts_nop 15\n\ts_nop 15\n\ts_nop 15" ::: "memory");
        __builtin_amdgcn_sched_barrier(0);
    }
    const float sink = INP(X, I_SINK)[layer * 16 + head];
    float m = sink;
#pragma unroll
    for (int kt = 0; kt < 5; ++kt)
#pragma unroll
        for (int reg = 0; reg < 16; ++reg) { const int jj = 32 * kt + crow(reg, h), dl = jj - r31; const bool ok = (dl >= 1) && (dl <= 128) && (kbase + jj >= 0);
            const float s = ok ? S[kt][reg] * 0.125f : -1e30f; S[kt][reg] = s; m = fmaxf(m, s); }
    m = fmaxf(m, __shfl_xor(m, 32));
    float sum = 0.f;
#pragma unroll
    for (int kt = 0; kt < 5; ++kt)
#pragma unroll
        for (int reg = 0; reg < 16; ++reg) { const float p = __expf(S[kt][reg] - m); S[kt][reg] = p; sum += p; }
    sum += __shfl_xor(sum, 32); sum += __expf(sink - m);
    const float inv = 1.0f / sum;
    f32x16 O[2];
#pragma unroll
    for (int dt = 0; dt < 2; ++dt)
#pragma unroll
        for (int i = 0; i < 16; ++i) O[dt][i] = 0.f;
    asm volatile("" : "+v"(O[0]), "+v"(O[1]));
#pragma unroll
    for (int kt = 0; kt < 5; ++kt)
#pragma unroll
        for (int s2 = 0; s2 < 2; ++s2) {
            u32x4 pw; pw.x = pk2(S[kt][8 * s2 + 0], S[kt][8 * s2 + 1]); pw.y = pk2(S[kt][8 * s2 + 2], S[kt][8 * s2 + 3]); pw.z = pk2(S[kt][8 * s2 + 4], S[kt][8 * s2 + 5]); pw.w = pk2(S[kt][8 * s2 + 6], S[kt][8 * s2 + 7]);
            const bf16x8 pf = __builtin_bit_cast(bf16x8, pw);
            const int tk = kbase + 32 * kt + 16 * s2 + 4 * h; const int t0 = tk < 0 ? 0 : tk, t1 = (tk + 8) < 0 ? 0 : (tk + 8);
            s16x4 vlo[2], vhi[2];
#pragma unroll
            for (int dt = 0; dt < 2; ++dt) { const bf16_t* vp = W_VT(X) + ((size_t)((b * 4 + g) * 64 + 32 * dt + r31)) * 4096; vlo[dt] = *(const s16x4*)(vp + t0); vhi[dt] = *(const s16x4*)(vp + t1); }
#pragma unroll
            for (int dt = 0; dt < 2; ++dt) {
                const bf16x8 vf = __builtin_shufflevector(vlo[dt], vhi[dt], 0, 1, 2, 3, 4, 5, 6, 7);
                O[dt] = MFMA32(vf, pf, O[dt]);
            }
            __builtin_amdgcn_sched_barrier(0); asm volatile("s_nop 15\n\ts_nop 15\n\ts_nop 15\n\ts_nop 15" ::: "memory"); __builtin_amdgcn_sched_barrier(0);
        }
    const size_t rq = rowb + q0 + r31;
#pragma unroll
    for (int dt = 0; dt < 2; ++dt)
#pragma unroll
        for (int rg = 0; rg < 4; ++rg) {
            const int d0 = 32 * dt + 8 * rg + 4 * h;
            const u32x2 gw2 = *(const u32x2*)(W_Z(X) + rq * DIN + C_GB + 64 * head + d0);
            const float g0 = __uint_as_float(gw2.x << 16), g1 = __uint_as_float(gw2.x & 0xffff0000u), g2 = __uint_as_float(gw2.y << 16), g3 = __uint_as_float(gw2.y & 0xffff0000u);
            u32x2 w; w.x = pk2(O[dt][4 * rg + 0] * inv * siluf_(g0), O[dt][4 * rg + 1] * inv * siluf_(g1)); w.y = pk2(O[dt][4 * rg + 2] * inv * siluf_(g2), O[dt][4 * rg + 3] * inv * siluf_(g3));
            *(u32x2*)(W_MIX(X) + rq * DM + 512 + 64 * head + d0) = w;
        }
}

DI void chunk_item(const Ctx& X, int layer, int it) {
    const int lane = X.lane, r31 = lane & 31, h = lane >> 5;
    const int sub = it & 7, hh = (it >> 3) & 3, chunk = it >> 5, ct = sub & 3, th = sub >> 2;
    const GAS float* chunk_b = INP(X, I_CB);
    const bf16_t* ap = W_VAT(X) + ((size_t)(128 * hh + 32 * ct + r31)) * 8192 + chunk * 128 + 8 * h;
    bf16x8 af[8];
#pragma unroll
    for (int ks = 0; ks < 8; ++ks) af[ks] = *(const bf16x8*)(ap + 16 * ks);
#pragma unroll
    for (int t2 = 0; t2 < 2; ++t2) {
        const int tt = 2 * th + t2, t = 32 * tt + r31;
        const bf16_t* bp = W_WSB(X) + ((size_t)((layer * 4 + hh) * 128 + t)) * 128 + 8 * h;
        f32x16 d;
#pragma unroll
        for (int i = 0; i < 16; ++i) d[i] = 0.f;
        asm volatile("" : "+v"(d));
#pragma unroll
        for (int ks = 0; ks < 8; ++ks) if (ks < 2 * (tt + 1)) d = MFMA32(af[ks], *(const bf16x8*)(bp + 16 * ks), d);
        __builtin_amdgcn_sched_barrier(0); asm volatile("s_nop 15\n\ts_nop 15\n\ts_nop 15\n\ts_nop 15\n\ts_nop 15\n\ts_nop 15" ::: "memory"); __builtin_amdgcn_sched_barrier(0);
        const size_t row = (size_t)chunk * 128 + t; const float bs = chunk_b[(layer * 4 + hh) * 128 + t];
#pragma unroll
        for (int rg = 0; rg < 4; ++rg) {
            const int c0 = 128 * hh + 32 * ct + 8 * rg + 4 * h;
            const u32x2 uw = *(const u32x2*)(W_Z(X) + row * DIN + C_UA + c0), gw2 = *(const u32x2*)(W_Z(X) + row * DIN + C_GA + c0);
            const float u0 = __uint_as_float(uw.x << 16), u1 = __uint_as_float(uw.x & 0xffff0000u), u2 = __uint_as_float(uw.y << 16), u3 = __uint_as_float(uw.y & 0xffff0000u);
            const float g0 = __uint_as_float(gw2.x << 16), g1 = __uint_as_float(gw2.x & 0xffff0000u), g2 = __uint_as_float(gw2.y << 16), g3 = __uint_as_float(gw2.y & 0xffff0000u);
            u32x2 w; w.x = pk2(u0 * (d[4 * rg + 0] + bs) * siluf_(g0), u1 * (d[4 * rg + 1] + bs) * siluf_(g1)); w.y = pk2(u2 * (d[4 * rg + 2] + bs) * siluf_(g2), u3 * (d[4 * rg + 3] + bs) * siluf_(g3));
            *(u32x2*)(W_MIX(X) + row * DM + c0) = w;
        }
    }
}

DI void sample_chunk_item(const Ctx& X, int layer, int it) {
    const int lane = X.lane, seq = it >> 2, hh = it & 3;
    const size_t row0 = 8192 + (size_t)seq * 8;
    const GAS float* chunk_b = INP(X, I_CB); const GAS float* chunk_w = INP(X, I_CW);
#pragma unroll
    for (int cpass = 0; cpass < 2; ++cpass) {
        const int ch = 128 * hh + 64 * cpass + lane;
        float va[8];
#pragma unroll
        for (int s = 0; s < 8; ++s) va[s] = bf2f(W_Z(X)[(row0 + s) * DIN + C_VA + ch]);
#pragma unroll
        for (int t = 0; t < 8; ++t) {
            float a = chunk_b[(layer * 4 + hh) * 128 + t];
#pragma unroll
            for (int s = 0; s < 8; ++s) if (s <= t) a += chunk_w[((size_t)((layer * 4 + hh) * 128 + t)) * 128 + s] * va[s];
            const float uu = bf2f(W_Z(X)[(row0 + t) * DIN + C_UA + ch]), gg = bf2f(W_Z(X)[(row0 + t) * DIN + C_GA + ch]);
            W_MIX(X)[(row0 + t) * DM + ch] = f2bf(uu * a * siluf_(gg));
        }
    }
}

DI void sample_attn_item(const Ctx& X, int layer, int it, LAS float* scr) {
    const int lane = X.lane, seq = it >> 4, head = it & 15, g = head >> 2;
    const size_t row0 = 8192 + (size_t)seq * 8;
    LAS float* Q = scr; LAS float* P = scr + 512;
    const bf16_t* z = W_Z(X);
#pragma unroll
    for (int i = 0; i < 8; ++i) Q[i * 64 + lane] = bf2f(z[(row0 + i) * DIN + C_Q + 64 * head + lane]) * 0.125f;
    LDS_FENCE();
    const float sink = INP(X, I_SINK)[layer * 16 + head];
    const GAS float* cache_k = INP(X, I_CK);
#pragma unroll 1
    for (int rd = 0; rd < 3; ++rd) {
        const int j = 64 * rd + lane;
        float kv[64];
        if (rd < 2) {
            const GAS float* kp = cache_k + (((size_t)(layer * 32 + seq) * 128 + j) * 4 + g) * 64;
#pragma unroll
            for (int d4 = 0; d4 < 16; ++d4) { const f32x4 v = *(const GAS f32x4*)(kp + 4 * d4); kv[4 * d4] = v[0]; kv[4 * d4 + 1] = v[1]; kv[4 * d4 + 2] = v[2]; kv[4 * d4 + 3] = v[3]; }
        } else {
            const int jn = (lane < 8) ? lane : 0;
            const bf16_t* kp = z + (row0 + jn) * DIN + C_K + 64 * g;
#pragma unroll
            for (int d8 = 0; d8 < 8; ++d8) { const u32x4 w = *(const u32x4*)(kp + 8 * d8);
#pragma unroll
                for (int e = 0; e < 4; ++e) { kv[8 * d8 + 2 * e] = __uint_as_float(w[e] << 16); kv[8 * d8 + 2 * e + 1] = __uint_as_float(w[e] & 0xffff0000u); } }
        }
#pragma unroll
        for (int i = 0; i < 8; ++i) {
            float a = 0.f;
#pragma unroll
            for (int d4 = 0; d4 < 16; ++d4) { const f32x4 q = *(const LAS f32x4*)(Q + i * 64 + 4 * d4); a += q[0] * kv[4 * d4] + q[1] * kv[4 * d4 + 1] + q[2] * kv[4 * d4 + 2] + q[3] * kv[4 * d4 + 3]; }
            const int dl = j - i; const bool ok = (j < 136) && (dl >= 1) && (dl <= 128);
            if (j < 136) P[j * 8 + i] = ok ? a : -1e30f;
        }
    }
    LDS_FENCE();
    float inv[8];
#pragma unroll
    for (int i = 0; i < 8; ++i) {
        const float s0 = P[lane * 8 + i], s1 = P[(64 + lane) * 8 + i], s2 = (lane < 8) ? P[(128 + lane) * 8 + i] : -1e30f;
        const float m = fmaxf(wave_max(fmaxf(fmaxf(s0, s1), s2)), sink);
        const float p0 = __expf(s0 - m), p1 = __expf(s1 - m), p2 = (lane < 8) ? __expf(s2 - m) : 0.f;
        inv[i] = 1.0f / (wave_sum(p0 + p1 + p2) + __expf(sink - m));
        P[lane * 8 + i] = p0; P[(64 + lane) * 8 + i] = p1; if (lane < 8) P[(128 + lane) * 8 + i] = p2;
    }
    LDS_FENCE();
    float o[8];
#pragma unroll
    for (int i = 0; i < 8; ++i) o[i] = 0.f;
    const GAS float* vp = INP(X, I_CV) + (((size_t)(layer * 32 + seq) * 128) * 4 + g) * 64 + lane;
#pragma unroll 16
    for (int j = 0; j < 128; ++j) { const float v = vp[(size_t)j * 256]; const f32x4 p0 = *(const LAS f32x4*)(P + j * 8), p1 = *(const LAS f32x4*)(P + j * 8 + 4);
        o[0] += p0[0] * v; o[1] += p0[1] * v; o[2] += p0[2] * v; o[3] += p0[3] * v; o[4] += p1[0] * v; o[5] += p1[1] * v; o[6] += p1[2] * v; o[7] += p1[3] * v; }
#pragma unroll
    for (int jn = 0; jn < 8; ++jn) { const float v = bf2f(z[(row0 + jn) * DIN + C_V + 64 * g + lane]); const f32x4 p0 = *(const LAS f32x4*)(P + (128 + jn) * 8), p1 = *(const LAS f32x4*)(P + (128 + jn) * 8 + 4);
        o[0] += p0[0] * v; o[1] += p0[1] * v; o[2] += p0[2] * v; o[3] += p0[3] * v; o[4] += p1[0] * v; o[5] += p1[1] * v; o[6] += p1[2] * v; o[7] += p1[3] * v; }
#pragma unroll
    for (int i = 0; i < 8; ++i) { const float gb = bf2f(z[(row0 + i) * DIN + C_GB + 64 * head + lane]); W_MIX(X)[(row0 + i) * DM + 512 + 64 * head + lane] = f2bf(o[i] * inv[i] * siluf_(gb)); }
    LDS_FENCE();
}

DI void phase_mixA(const Ctx& X, int layer) {
    LAS float* scr = (LAS float*)(X.lds + X.wave * WSCR);
    constexpr int N_ATT = 4096, N_CH = 2048, N_SA = 512, N_SC = 128, N_S5 = 2048;
    if (X.ngw == 2048) {
        if (X.gw < 512) attn_item(X, layer, X.gw);
        else for (int it = X.gw; it < N_ATT; it += 1536) attn_item(X, layer, it);
    } else for (int it = X.gw; it < N_ATT; it += X.ngw) attn_item(X, layer, it);
    for (int it = X.gw; it < N_SA; it += X.ngw) sample_attn_item(X, layer, it, scr);
    for (int it = X.gw; it < N_SC; it += X.ngw) sample_chunk_item(X, layer, it);
    for (int it = X.gw; it < N_S5; it += X.ngw) s5_wave_unit<false>(X, layer, it >> 3, it & 7, scr, nullptr);
    if (gridDim.x >= 72 && blockIdx.x >= 64 && blockIdx.x < 72) { asm volatile("s_waitcnt vmcnt(0) lgkmcnt(0)" ::: "memory"); __syncthreads(); phase_s5c(X, layer, 256 + (int)blockIdx.x - 64, 264); }
    else if (gridDim.x < 72) { asm volatile("s_waitcnt vmcnt(0) lgkmcnt(0)" ::: "memory"); __syncthreads(); phase_s5c(X, layer, 256 + (int)blockIdx.x, 264); }
}

DI void phase_carry(const Ctx& X, int layer) {
    const int lane = X.lane;
    for (int it = X.gw; it < 64; it += X.ngw) {
        const int b = it >> 5, g = it & 31, lg = layer * 32 + g;
        const float2 aT = W_AT(X)[lg * 64 + lane];
        const float2* Ep = W_E(X) + ((size_t)(b * 128) * 32 + g) * 64 + lane;
        float2* Hp = W_H0(X) + ((size_t)(b * 128) * 32 + g) * 64 + lane;
        float hr = 0.f, hi = 0.f;
        for (int c = 0; c < 128; c += 16) {
            float2 e[16];
#pragma unroll
            for (int j = 0; j < 16; ++j) e[j] = Ep[(size_t)(c + j) * 2048];
#pragma unroll
            for (int j = 0; j < 16; ++j) { Hp[(size_t)(c + j) * 2048] = make_float2(hr, hi); const float nr = aT.x * hr - aT.y * hi + e[j].x, ni = aT.x * hi + aT.y * hr + e[j].y; hr = nr; hi = ni; }
        }
    }
}

DI void phase_final(const Ctx& X) {
    const GAS float* final_g = INP(X, I_FG);
    for (int m = X.gw; m < MROWS; m += X.ngw) {
        const float rs = rsqrtf((float)W_ROWSS(X)[4 * MROWS + m] * (2.3283064365386963e-10f / 2048.0f) + 1e-5f);
#pragma unroll
        for (int j = 0; j < 8; ++j) { const int c = 4 * X.lane + 256 * j; const f32x4 v = *(const f32x4*)(W_XRES(X) + (size_t)m * DM + c); const f32x4 gg = *(const GAS f32x4*)(final_g + c);
            *(f32x4*)(X.out + OFF_Y + (size_t)m * DM + c) = v * rs * gg; }
    }
}

#define XB_TMO      128
#define XB_XCNT(j)  (256  + 64 * (j))
#define XB_XSUB(j)  (1280 + 64 * (j))
#define XB_XGEN(j)  (2304 + 64 * (j))
#define XB_TOP      3328
#define XB_TOPGEN   3392
#define XCD_BAR_WORDS 3456
#define XB_SPIN_CAP (1u << 18)

__device__ __forceinline__ unsigned xb_ld(unsigned* p)              { return __hip_atomic_load(p, __ATOMIC_RELAXED, __HIP_MEMORY_SCOPE_AGENT); }
__device__ __forceinline__ unsigned xb_add(unsigned* p, unsigned v) { return __hip_atomic_fetch_add(p, v, __ATOMIC_RELAXED, __HIP_MEMORY_SCOPE_AGENT); }
__device__ __forceinline__ unsigned xb_xcc_id() { return (unsigned)__builtin_amdgcn_s_getreg((3 << 11) | 20) & 0xFu; }
#define XB_SPIN(cond, bar) do { unsigned _sp = 0; while (cond) { __builtin_amdgcn_s_sleep(1); \
    if ((++_sp & 255u) == 0u) { if (xb_ld(&(bar)[XB_TMO])) break; if (_sp > XB_SPIN_CAP) { atomicAdd(&(bar)[XB_TMO], 1u); break; } } } } while (0)

struct XcdBarrier {
    unsigned* bar; unsigned x;
    volatile LAS unsigned* st;
};

__device__ __forceinline__ XcdBarrier xcd_barrier_post(unsigned* bar, volatile LAS unsigned* st) {
    XcdBarrier b; b.bar = bar; b.x = xb_xcc_id(); b.st = st;
    if (threadIdx.x == 0) (void)xb_add(&bar[XB_XCNT(b.x)], 1u);
    return b;
}
__device__ __forceinline__ void xcd_barrier_complete(unsigned* bar, unsigned x, unsigned& nloc, unsigned& nx) {
    const unsigned G = gridDim.x * gridDim.y * gridDim.z;
    unsigned sum, cnt, mine, sp = 0u;
    for (;;) {
        sum = 0u; cnt = 0u; mine = 0u;
#pragma unroll
        for (unsigned j = 0; j < 16; ++j) { const unsigned c = xb_ld(&bar[XB_XCNT(j)]); sum += c; cnt += (c > 0u) ? 1u : 0u; mine = (j == x) ? c : mine; }
        if (sum == G) break;
        __builtin_amdgcn_s_sleep(1);
        if ((++sp & 255u) == 0u) { if (xb_ld(&bar[XB_TMO])) break; if (sp > XB_SPIN_CAP) { atomicAdd(&bar[XB_TMO], 1u); break; } }
    }
    nloc = mine > 0u ? mine : 1u; nx = cnt > 0u ? cnt : 1u;
}

__device__ __forceinline__ void xcd_barrier(const XcdBarrier& b) {
    asm volatile("s_waitcnt vmcnt(0)" ::: "memory");
    __syncthreads();
    if (threadIdx.x == 0) {
        unsigned* bar = b.bar;
        __builtin_amdgcn_s_waitcnt(0);
        unsigned nloc = b.st[0], nx = b.st[1];
        if (nloc == 0u) { xcd_barrier_complete(bar, b.x, nloc, nx); b.st[0] = nloc; b.st[1] = nx; }
        const unsigned old = xb_add(&bar[XB_XSUB(b.x)], 1u);
        const unsigned gen = old / nloc;
        if (old + 1u == (gen + 1u) * nloc) {
            __builtin_amdgcn_fence(__ATOMIC_RELEASE, "agent");
            asm volatile("s_waitcnt vmcnt(0)" ::: "memory");
            const unsigned og = xb_add(&bar[XB_TOP], 1u);
            const unsigned tg = og / nx;
            if (og + 1u == (tg + 1u) * nx) xb_add(&bar[XB_TOPGEN], 1u);
            else XB_SPIN(xb_ld(&bar[XB_TOPGEN]) == tg, bar);
            __builtin_amdgcn_fence(__ATOMIC_ACQUIRE, "agent");
            xb_add(&bar[XB_XGEN(b.x)], 1u);
            asm volatile("s_waitcnt vmcnt(0)" ::: "memory");
        } else {
            XB_SPIN(xb_ld(&bar[XB_XGEN(b.x)]) == gen, bar);
            __builtin_amdgcn_fence(__ATOMIC_ACQUIRE, "agent");
            asm volatile("s_waitcnt vmcnt(0)" ::: "memory");
        }
    }
    __syncthreads();
}

struct Args { const float* in[23]; float* out; unsigned char* ws; int ph_lo, ph_hi; };
constexpr int N_PHASES = 2 + 5 * NLAYER;

__global__ void __launch_bounds__(NTHREADS, 2) fwd_megakernel(Args a) {
    extern __shared__ __attribute__((aligned(16))) unsigned char lds_raw[];
    Ctx X0;
    X0.lds = (LAS unsigned char*)lds_raw;
    X0.lane = threadIdx.x & 63; X0.wave = __builtin_amdgcn_readfirstlane(threadIdx.x >> 6);
    X0.gw = blockIdx.x * NWAVES + X0.wave; X0.ngw = gridDim.x * NWAVES;
    X0.out = a.out; X0.ws = a.ws;
    if (threadIdx.x < 23) *(LAS unsigned long long*)(X0.lds + PTR_OFF + 8 * threadIdx.x) = (unsigned long long)a.in[threadIdx.x];
    if (threadIdx.x == 0) { *(volatile LAS unsigned*)(X0.lds + XB_LDS_OFF) = 0u; *(volatile LAS unsigned*)(X0.lds + XB_LDS_OFF + 4) = 0u; }
    LDS_FENCE(); __syncthreads();
    XcdBarrier xbar = xcd_barrier_post((unsigned*)(a.ws + WS_XBAR), (volatile LAS unsigned*)(X0.lds + XB_LDS_OFF));

    for (int ph = a.ph_lo; ph < a.ph_hi; ++ph) {
        if (ph > a.ph_lo) {
            if (ph == a.ph_lo + 1) {
                asm volatile("s_waitcnt vmcnt(0) lgkmcnt(0)" ::: "memory");
                __builtin_amdgcn_fence(__ATOMIC_RELEASE, "agent");
                asm volatile("s_waitcnt vmcnt(0)" ::: "memory");
                __syncthreads();
                cg::this_grid().sync();
                __builtin_amdgcn_fence(__ATOMIC_ACQUIRE, "agent");
                asm volatile("s_waitcnt vmcnt(0)" ::: "memory");
                __syncthreads();
            } else {
                asm volatile("s_waitcnt vmcnt(0) lgkmcnt(0)" ::: "memory");
                xcd_barrier(xbar);
            }
        } else { __builtin_amdgcn_fence(__ATOMIC_ACQUIRE, "agent"); asm volatile("s_waitcnt vmcnt(0)" ::: "memory"); __syncthreads(); }
        Ctx X = X0;
        asm volatile("" : "+v"(X.lane), "+s"(X.wave), "+s"(X.gw), "+s"(X.ngw));
        if (ph == 100) { for (int i = X.gw * 64 + X.lane; i < MROWS * 512; i += X.ngw * 64) X.out[i] = bf2f(W_Z(X)[(size_t)(i >> 9) * DIN + C_UC + (i & 511)]); }
        else if (ph == 101) { for (int i = X.gw * 64 + X.lane; i < 2 * 128 * 32 * 64 * 2; i += X.ngw * 64) X.out[8 * 1024 * 1024 + i] = ((const float*)W_E(X))[i]; }
        else if (ph == 0) phase_prologue(X);
        else if (ph == N_PHASES - 1) phase_final(X);
        else {
            const int l = (ph - 1) / 5, k = (ph - 1) % 5;
            if (k == 0) {
                pg8::Gemm g{W_XB(X), W_WIT(X) + (size_t)l * DIN * DM, MROWS, DIN, DM}; pg8::StaticOrder S; S.init(MROWS, DIN, (int)gridDim.x, (int)blockIdx.x);
                pg8::EpiIn E{X.ws, X.out, l};
                pg8::gemm_phase<pg8::EpiIn, pg8::StaticOrder, true, true>(X.lds, g, S, E);
            } else if (k == 1) phase_mixA(X, l);
            else if (k == 2) {
                phase_carry(X, l);
                for (int it = X.gw; it < 2048; it += X.ngw) chunk_item(X, l, it);
                if (gridDim.x >= 16 && blockIdx.x < gridDim.x - 8 && l + 1 < NLAYER) { asm volatile("s_waitcnt vmcnt(0) lgkmcnt(0)" ::: "memory"); convert_layer_weights(X, l + 1, X.gw, (int)(gridDim.x - 8) * NWAVES); }
                if (gridDim.x >= 16 && blockIdx.x >= gridDim.x - 8) {
                    asm volatile("s_waitcnt vmcnt(0) lgkmcnt(0)" ::: "memory"); __syncthreads();
                    pg8::Gemm g{W_MIX(X), W_WOT(X) + (size_t)l * DM * DM, MROWS, DM, DM}; pg8::SampleOrder S{(int)blockIdx.x, (int)gridDim.x};
                    pg8::EpiOut E{l == 0 ? (const float*)INP(X, I_XP) : (const float*)W_XRES(X), l == 0 ? (const float*)INP(X, I_XS) : (const float*)(W_XRES(X) + (size_t)8192 * DM), X.ws, l};
                    pg8::gemm_phase<pg8::EpiOut, pg8::SampleOrder, true, true>(X.lds, g, S, E);
                }
            }
            else if (k == 3) phase_s5c(X, l, (int)blockIdx.x, 256);
            else {
                pg8::Gemm g{W_MIX(X), W_WOT(X) + (size_t)l * DM * DM, MROWS, DM, DM}; pg8::StaticOrder S; S.init(gridDim.x >= 16 ? MPROMPT : MROWS, DM, (int)gridDim.x, (int)blockIdx.x);
                pg8::EpiOut E{l == 0 ? (const float*)INP(X, I_XP) : (const float*)W_XRES(X), l == 0 ? (const float*)INP(X, I_XS) : (const float*)(W_XRES(X) + (size_t)8192 * DM), X.ws, l};
                pg8::gemm_phase<pg8::EpiOut, pg8::StaticOrder, true, true>(X.lds, g, S, E);
            }
        }
    }
    asm volatile("s_waitcnt vmcnt(0)" ::: "memory"); __builtin_amdgcn_fence(__ATOMIC_RELEASE, "agent"); asm volatile("s_waitcnt vmcnt(0)" ::: "memory");
}

extern "C" void kernel_launch(void* const* d_in, const int* in_sizes, int n_in, void* d_out, int out_size, void* d_ws, size_t ws_size, hipStream_t stream) {
    static int grid = 0;
    if (grid == 0) {
        if (n_in != 23 || (size_t)out_size != OUT_TOTAL || ws_size < WS_END) { fprintf(stderr, "kernel_launch: unexpected shapes (n_in %d, out %d, ws %zu); nothing launched\n", n_in, out_size, ws_size); grid = -1; return; }
        int dev = 0, cus = 0, per_cu = 0;
        if (hipGetDevice(&dev) != hipSuccess || hipDeviceGetAttribute(&cus, hipDeviceAttributeMultiprocessorCount, dev) != hipSuccess) { grid = -1; return; }
        if (hipFuncSetAttribute((const void*)fwd_megakernel, hipFuncAttributeMaxDynamicSharedMemorySize, LDS_BYTES) != hipSuccess) { fprintf(stderr, "kernel_launch: hipFuncSetAttribute failed\n"); grid = -1; return; }
        if (hipOccupancyMaxActiveBlocksPerMultiprocessor(&per_cu, (const void*)fwd_megakernel, NTHREADS, LDS_BYTES) != hipSuccess || per_cu < 1) { fprintf(stderr, "kernel_launch: occupancy query says %d blocks/CU\n", per_cu); per_cu = 1; }
        (void)hipGetLastError();
        grid = cus;
    }
    if (grid < 0) return;
    if (hipMemsetAsync((char*)d_ws + WS_CTL, 0, CTL_ZERO_BYTES, stream) != hipSuccess) { fprintf(stderr, "kernel_launch: memset failed\n"); return; }
    Args a{};
    for (int i = 0; i < 23; ++i) a.in[i] = (const float*)d_in[i];
    a.out = (float*)d_out; a.ws = (unsigned char*)d_ws;
#if N_LAUNCH_MODE == 1
    a.ph_lo = 0; a.ph_hi = N_PHASES;
    void* args[] = {&a};
    hipError_t e = hipLaunchCooperativeKernel((const void*)fwd_megakernel, dim3(grid), dim3(NTHREADS), args, LDS_BYTES, stream);
    if (e != hipSuccess) fprintf(stderr, "kernel_launch: cooperative launch failed: %s (grid %d)\n", hipGetErrorString(e), grid);
#else
#ifndef DBG_MAX_PH
#define DBG_MAX_PH N_PHASES
#endif
    for (int ph = 0; ph < DBG_MAX_PH; ++ph) {
        a.ph_lo = ph; a.ph_hi = ph + 1;
        hipLaunchKernelGGL(fwd_megakernel, dim3(grid), dim3(NTHREADS), LDS_BYTES, stream, a);
    }
#ifdef DBG_DUMP
    a.ph_lo = DBG_DUMP; a.ph_hi = DBG_DUMP + 1; hipLaunchKernelGGL(fwd_megakernel, dim3(grid), dim3(NTHREADS), LDS_BYTES, stream, a);
#endif
#endif
}
```

```cpp
#include <hip/hip_runtime.h>
#include <hip/hip_cooperative_groups.h>
#include <cstdio>
#include <cstdint>
namespace cg = cooperative_groups;

#ifndef N_LAUNCH_MODE
#define N_LAUNCH_MODE 1
#endif

constexpr int DM = 2048, DIN = 5120, MROWS = 8448, MPROMPT = 8192, NLAYER = 4;
constexpr int C_UA = 0, C_VA = 512, C_GA = 1024, C_Q = 1536, C_K = 2560, C_V = 2816, C_GB = 3072, C_UC = 4096, C_GC = 4608;
constexpr size_t OFF_Y = 0, OFF_KP = 17301504, OFF_VP = 17563648, OFF_KS = 17825792, OFF_VS = 18087936,
                 OFF_HRP = 18350080, OFF_HIP = 18366464, OFF_HRS = 18382848, OFF_HIS = 18644992, OFF_VA = 18907136, OUT_TOTAL = 19431424;
constexpr size_t MiB = 1u << 20;
constexpr size_t WS_CTL = 0, CTL_ZERO_BYTES = 1 * MiB, WS_ROWSS = 65536;
constexpr size_t WS_AB = 1 * MiB, WS_AT = WS_AB + 65536, WS_BB = WS_AT + 65536, WS_CC = WS_BB + 524288, WS_ROPE = WS_CC + 524288, WS_WSB = WS_ROPE + 262656 + 1472  ;
constexpr size_t WS_WGT = 4 * MiB, WS_WOT = 6 * MiB, WS_WIT = 38 * MiB, WS_XB = 118 * MiB, WS_XRES = 151 * MiB, WS_Z = 217 * MiB,
                 WS_MIX = 300 * MiB, WS_VT = 333 * MiB, WS_VAT = 337 * MiB, WS_E = 345 * MiB, WS_H0 = 349 * MiB, WS_END = 353 * MiB;
static_assert(WS_WSB + 524288 <= WS_WGT, "tables fit");
static_assert(WS_WSB % 16 == 0, "align");

namespace pg8 {
#define PG8_LAS __attribute__((address_space(3)))
typedef unsigned short bf16_t;
typedef short bf16x8 __attribute__((ext_vector_type(8)));
typedef float f32x4 __attribute__((ext_vector_type(4)));
typedef unsigned u32x4 __attribute__((ext_vector_type(4)));
typedef unsigned u32x2 __attribute__((ext_vector_type(2)));
constexpr int BM = 256, BK = 64, HALF = 128, HTB = HALF * BK * 2  , STAGE_BYTES = 8 * HTB, NXCD = 8, WGM = 8;
__host__ __device__ __forceinline__ int lds_byte(int r, int c) { const int st = (r >> 4) * 2 + (c >> 5), rr = r & 15, cc = c & 31, ob = rr * 64 + cc * 2; return st * 1024 + (ob ^ (((ob >> 9) & 1) << 5)); }
__host__ __device__ __forceinline__ void stage_rc(int b, int& R, int& C) { const int st = b / 1024, sb = b % 1024, swz = sb ^ (((sb >> 9) & 1) << 5); R = (st >> 1) * 16 + swz / 64; C = (st & 1) * 32 + (swz % 64) / 2; }
__host__ __device__ __forceinline__ int perm32(int rho) { const int n = rho >> 4, i = rho & 15; return 8 * (i >> 2) + 4 * n + (i & 3); }

struct Unit { int pm, pn; };
struct Gemm { const bf16_t* A; const bf16_t* Bt; int M, N, K; };

struct StaticOrder {
    int nM, nN, nwg, G, c;
    __host__ __device__ void init(int M, int N, int G_, int c_) { nM = M / BM; nN = N / BM; nwg = nM * nN; G = G_; c = c_; }
    __host__ __device__ bool next(int i, Unit& u) const {
        const long L = (long)i * G + c; if (L >= nwg) return false;
        int wgid = (int)L; { const int q = nwg / NXCD, r = nwg % NXCD, xcd = wgid % NXCD, off = wgid / NXCD; wgid = (xcd < r ? xcd * (q + 1) : r * (q + 1) + (xcd - r) * q) + off; }
        const int nig = WGM * nN, gid = wgid / nig, fm = gid * WGM, gsz = (nM - fm) < WGM ? (nM - fm) : WGM;
        u.pm = fm + ((wgid % nig) % gsz); u.pn = (wgid % nig) / gsz; return true;
    }
    __device__ __forceinline__ void a_ready(const Unit&) const {}
    __device__ __forceinline__ void done(const Unit&) const {}
};

struct SampleOrder {
    int c, G;
    __device__ __forceinline__ bool next(int i, Unit& u) const { if (i != 0 || c < G - 8) return false; u.pm = 32; u.pn = c - (G - 8); return true; }
    __device__ __forceinline__ void a_ready(const Unit&) const {}
    __device__ __forceinline__ void done(const Unit&) const {}
};
typedef __bf16 bf16x2_t __attribute__((ext_vector_type(2)));
typedef float f32x2_t __attribute__((ext_vector_type(2)));
__device__ __forceinline__ unsigned pk2(float lo, float hi) { f32x2_t v = {lo, hi}; bf16x2_t b = __builtin_convertvector(v, bf16x2_t); return __builtin_bit_cast(unsigned, b); }
__device__ __forceinline__ bf16_t f2bf(float f) { return (bf16_t)(pk2(f, 0.f) & 0xffffu); }
__device__ __forceinline__ float bf2f(bf16_t h) { return __uint_as_float(((unsigned)h) << 16); }

struct EpiIn {
    static constexpr bool PERM = true, AFTER_DRAIN = false;
    unsigned char* ws; float* out; int layer;
    __device__ __forceinline__ void operator()(const f32x4 (&acc)[2][2][4][2], const Unit& u, int wr, int wc, int fr_, int fq_) const {
        int lane_ = threadIdx.x & 63; asm volatile("" : "+v"(lane_));
        const int fr = lane_ & 15, fq = lane_ >> 4;
        const int pn = u.pn, pm = u.pm;
        bf16_t* z = (bf16_t*)(ws + WS_Z); const unsigned long long* rowss = (const unsigned long long*)(ws + WS_ROWSS) + layer * MROWS; const float2* rope = (const float2*)(ws + WS_ROPE);
        bf16_t* vT = (bf16_t*)(ws + WS_VT); bf16_t* vaT = (bf16_t*)(ws + WS_VAT);
        const bool is_rope = (pn >= 6 && pn <= 10) && ((wc & 1) == 0);
#pragma unroll
        for (int ai = 0; ai < 2; ++ai)
#pragma unroll
            for (int m = 0; m < 4; ++m) {
                const int r = pm * BM + ai * HALF + wr * 64 + m * 16 + fr;
                const float rs = rsqrtf((float)rowss[r] * (2.3283064365386963e-10f / 2048.0f) + 1e-5f);
                const int pi = (r < 8192) ? (r & 4095) : (4096 + ((r - 8192) & 7));
#pragma unroll
                for (int bj = 0; bj < 2; ++bj) {
                    f32x4 v0 = acc[ai][bj][m][0] * rs, v1 = acc[ai][bj][m][1] * rs;
                    const int c = pn * BM + bj * HALF + wc * 32 + 8 * fq;
                    if (is_rope) {
                        f32x4 p0, p1;
#pragma unroll
                        for (int e = 0; e < 4; ++e) { p0[e] = __shfl_xor(v0[e], 16); p1[e] = __shfl_xor(v1[e], 16); }
                        if (fq < 2) {
                            const float2* cs = rope + (size_t)pi * 8;
                            const float sg = (fq == 0) ? -1.0f : 1.0f;
#pragma unroll
                            for (int e = 0; e < 4; ++e) {
                                const float2 c0 = cs[e], c1 = cs[4 + e];
                                v0[e] = v0[e] * c0.x + sg * p0[e] * c0.y;
                                v1[e] = v1[e] * c1.x + sg * p1[e] * c1.y;
                            }
                        }
                    }
                    u32x4 w; w.x = pk2(v0[0], v0[1]); w.y = pk2(v0[2], v0[3]); w.z = pk2(v1[0], v1[1]); w.w = pk2(v1[2], v1[3]);
                    *(u32x4*)(z + (size_t)r * DIN + c) = w;
                    if (pn == 10 || pn == 11) {
                        const int cc = c - pn * BM;
                        float* o = nullptr;
                        if (pm == 32) o = out + (pn == 10 ? OFF_KS : OFF_VS) + ((size_t)(layer * 256 + (r - 8192))) * 256 + cc;
                        else if ((pm & 15) == 15 && ai == 1) o = out + (pn == 10 ? OFF_KP : OFF_VP) + ((size_t)((layer * 2 + (pm >> 4)) * 128 + ((r & 4095) - 3968))) * 256 + cc;
                        if (o) { *(f32x4*)o = v0; *(f32x4*)(o + 4) = v1; }
                        if (pn == 11 && pm < 32) {
                            const int b = r >> 12, t = r & 4095;
                            bf16_t* vp = vT + ((size_t)(b * 256 + cc)) * 4096 + t;
#pragma unroll
                            for (int e = 0; e < 8; ++e) vp[(size_t)e * 4096] = (bf16_t)((w[e >> 1] >> (16 * (e & 1))) & 0xffffu);
                        }
                    }
                    if (pn == 2 || pn == 3) {
                        const int ch = c - C_VA;
                        if (pm < 32) {
                            bf16_t* vp = vaT + (size_t)ch * 8192 + r;
#pragma unroll
                            for (int e = 0; e < 8; ++e) vp[(size_t)e * 8192] = (bf16_t)((w[e >> 1] >> (16 * (e & 1))) & 0xffffu);
                        } else {
                            float* o = out + OFF_VA + ((size_t)(layer * 256 + (r - 8192))) * 512 + ch;
                            *(f32x4*)o = v0; *(f32x4*)(o + 4) = v1;
                        }
                    }
                }
            }
    }
};

struct EpiOut {
    static constexpr bool PERM = false, AFTER_DRAIN = false;
    const float* xp; const float* xs; unsigned char* ws; int layer;
    __device__ __forceinline__ void operator()(const f32x4 (&acc)[2][2][4][2], const Unit& u, int wr, int wc, int fr_, int fq_) const {
        int lane_ = threadIdx.x & 63; asm volatile("" : "+v"(lane_));
        const int fr = lane_ & 15, fq = lane_ >> 4;
        float* xres = (float*)(ws + WS_XRES); bf16_t* xb = (bf16_t*)(ws + WS_XB); unsigned long long* rowss_next = (unsigned long long*)(ws + WS_ROWSS) + (layer + 1) * MROWS;
#pragma unroll
        for (int ai = 0; ai < 2; ++ai)
#pragma unroll
            for (int m = 0; m < 4; ++m) {
                const int r = u.pm * BM + ai * HALF + wr * 64 + m * 16 + fr;
                const float* xo = (r < 8192) ? (xp + (size_t)r * DM) : (xs + (size_t)(r - 8192) * DM);
                float ss = 0.f;
#pragma unroll
                for (int bj = 0; bj < 2; ++bj)
#pragma unroll
                    for (int n = 0; n < 2; ++n) {
                        const int c = u.pn * BM + bj * HALF + wc * 32 + 16 * n + 4 * fq;
                        const f32x4 o = *(const f32x4*)(xo + c) + acc[ai][bj][m][n];
                        *(f32x4*)(xres + (size_t)r * DM + c) = o;
                        u32x2 w; w.x = pk2(o[0], o[1]); w.y = pk2(o[2], o[3]);
                        *(u32x2*)(xb + (size_t)r * DM + c) = w;
                        ss += (o[0] * o[0] + o[1] * o[1]) + (o[2] * o[2] + o[3] * o[3]);
                    }
                ss += __shfl_xor(ss, 16); ss += __shfl_xor(ss, 32);
                if (fq == 0) atomicAdd(rowss_next + r, (unsigned long long)(ss * 4294967296.0f));
                asm volatile("" ::: "memory");
            }
    }
};

template <class Epi, class Sched, bool ALIGN_EPI = false, bool SP2 = false>
__device__ __forceinline__ void gemm_phase(PG8_LAS unsigned char* lds, const Gemm g, const Sched& S, const Epi& E) {
    int tid_ = threadIdx.x; asm volatile("" : "+v"(tid_));
    const int tid = tid_, wid = __builtin_amdgcn_readfirstlane(tid >> 6), lane = tid & 63, wr = wid >> 2, wc = wid & 3, fr = lane & 15, fq = lane >> 4;
    const int K = g.K, nt = K / BK;
    unsigned voffA[2], voffB[2];
#pragma unroll
    for (int i = 0; i < 2; ++i) { int R, C; stage_rc(tid * 16 + i * 8192, R, C); const int Rb = Epi::PERM ? ((R & ~31) + perm32(R & 31)) : R;
        voffA[i] = (unsigned)(R * K + C) * 2u; voffB[i] = (unsigned)(Rb * K + C) * 2u; }
    const size_t kstep = (size_t)(BK * 2);
    const size_t hstep = (size_t)HALF * K * 2;
    const size_t tstep = 2 * hstep;
    const unsigned ldsw = (unsigned)wid * 1024u;
    const int aoff = lds_byte(wr * 64 + fr, fq * 8), boff = lds_byte(wc * 32 + fr, fq * 8);
#define PG8_SA(b, h) (((b) * 2 + (h)) * HTB)
#define PG8_SB(b, h) ((4 + (b) * 2 + (h)) * HTB)
#define PG8_STAGE(bufoff, gbase, voff) do { _Pragma("unroll") for (int _i = 0; _i < 2; ++_i) \
        __builtin_amdgcn_global_load_lds((const unsigned*)((const char*)(gbase) + (voff)[_i]), (PG8_LAS unsigned*)(lds + (bufoff) + ldsw + _i * 8192), 16, 0, 0); } while (0)
#define PG8_LDA(dst, b, h) do { _Pragma("unroll") for (int m = 0; m < 4; ++m) _Pragma("unroll") for (int k = 0; k < 2; ++k) dst[m][k] = *(const PG8_LAS bf16x8*)(lds + PG8_SA(b, h) + aoff + m * 2048 + k * 1024); } while (0)
#define PG8_LDB(dst, b, h) do { _Pragma("unroll") for (int n = 0; n < 2; ++n) _Pragma("unroll") for (int k = 0; k < 2; ++k) dst[n][k] = *(const PG8_LAS bf16x8*)(lds + PG8_SB(b, h) + boff + n * 2048 + k * 1024); } while (0)
#define PG8_MMA(ai, bj, At, Bt) do { __builtin_amdgcn_s_setprio(1); _Pragma("unroll") for (int m = 0; m < 4; ++m) _Pragma("unroll") for (int n = 0; n < 2; ++n) _Pragma("unroll") for (int k = 0; k < 2; ++k) \
        acc[ai][bj][m][n] = __builtin_amdgcn_mfma_f32_16x16x32_bf16(Bt[n][k], At[m][k], acc[ai][bj][m][n], 0, 0, 0); __builtin_amdgcn_s_setprio(0); } while (0)
#define PG8_WAIT_V(n) asm volatile("s_waitcnt vmcnt(" #n ")" ::: "memory")
#define PG8_WAIT_L(n) asm volatile("s_waitcnt lgkmcnt(" #n ")" ::: "memory")
#define PG8_BAR __builtin_amdgcn_s_barrier()
#define PG8_SCHED __builtin_amdgcn_sched_barrier(0)
    Unit cur, nxt; int ui = 0;
    if (!S.next(0, cur)) return;
    f32x4 acc[2][2][4][2];
#pragma unroll
    for (int a = 0; a < 2; ++a)
#pragma unroll
        for (int b = 0; b < 2; ++b)
#pragma unroll
            for (int m = 0; m < 4; ++m)
#pragma unroll
                for (int n = 0; n < 2; ++n) acc[a][b][m][n] = (f32x4){0.f, 0.f, 0.f, 0.f};
    bf16x8 At[4][2], B0[2][2], B1[2][2];
    const char* cA = (const char*)g.A + (size_t)cur.pm * tstep; const char* cB = (const char*)g.Bt + (size_t)cur.pn * tstep;
    S.a_ready(cur);
    if constexpr (SP2) {
        PG8_STAGE(PG8_SB(0, 0), cB, voffB); PG8_STAGE(PG8_SB(0, 1), cB + hstep, voffB); PG8_STAGE(PG8_SA(0, 0), cA, voffA); PG8_STAGE(PG8_SA(0, 1), cA + hstep, voffA);
        if (wr == 1) PG8_BAR;
        PG8_WAIT_V(2); PG8_BAR;
        PG8_STAGE(PG8_SB(1, 0), cB + kstep, voffB); PG8_STAGE(PG8_SA(1, 0), cA + kstep, voffA); PG8_STAGE(PG8_SB(1, 1), cB + hstep + kstep, voffB);
        PG8_WAIT_V(6); PG8_BAR;
    } else {
        PG8_STAGE(PG8_SB(0, 0), cB, voffB); PG8_STAGE(PG8_SA(0, 0), cA, voffA); PG8_STAGE(PG8_SB(0, 1), cB + hstep, voffB); PG8_STAGE(PG8_SA(0, 1), cA + hstep, voffA);
        if (wr == 1) PG8_BAR;
        PG8_WAIT_V(4); PG8_BAR;
        PG8_STAGE(PG8_SB(1, 0), cB + kstep, voffB); PG8_STAGE(PG8_SA(1, 0), cA + kstep, voffA); PG8_STAGE(PG8_SB(1, 1), cB + hstep + kstep, voffB);
        PG8_WAIT_V(6); PG8_BAR;
    }
    for (;;) {
        const bool has_next = S.next(ui + 1, nxt);
        const char* nA = has_next ? (const char*)g.A + (size_t)nxt.pm * tstep : cA; const char* nB = has_next ? (const char*)g.Bt + (size_t)nxt.pn * tstep : cB;
        for (int t = 0; t < nt; t += 2) {
            const bool last = (t == nt - 2);
            const char* a1 = cA + (size_t)(t + 1) * kstep;
            const char* a2 = last ? nA : cA + (size_t)(t + 2) * kstep; const char* b2 = last ? nB : cB + (size_t)(t + 2) * kstep;
            const char* a3 = a2 + kstep; const char* b3 = b2 + kstep;
            if (last && has_next) S.a_ready(nxt);
            if constexpr (SP2) {
            PG8_LDB(B0, 0, 0); PG8_LDB(B1, 0, 1); PG8_SCHED; PG8_LDA(At, 0, 0); PG8_STAGE(PG8_SA(1, 1), a1 + hstep, voffA);
            PG8_WAIT_V(8); PG8_WAIT_L(0); PG8_BAR; PG8_MMA(0, 0, At, B0); PG8_MMA(0, 1, At, B1); PG8_BAR; PG8_SCHED;
            PG8_LDA(At, 0, 1); PG8_STAGE(PG8_SB(0, 0), b2, voffB); PG8_STAGE(PG8_SB(0, 1), b2 + hstep, voffB); PG8_STAGE(PG8_SA(0, 0), a2, voffA);
            PG8_WAIT_V(8); PG8_WAIT_L(0); PG8_BAR; PG8_MMA(1, 0, At, B0); PG8_MMA(1, 1, At, B1); PG8_BAR; PG8_SCHED;
            PG8_LDB(B0, 1, 0); PG8_LDB(B1, 1, 1); PG8_SCHED; PG8_LDA(At, 1, 0); PG8_STAGE(PG8_SA(0, 1), a2 + hstep, voffA);
            PG8_WAIT_V(8); PG8_WAIT_L(0); PG8_BAR; PG8_MMA(0, 0, At, B0); PG8_MMA(0, 1, At, B1); PG8_BAR; PG8_SCHED;
            PG8_LDA(At, 1, 1); PG8_STAGE(PG8_SB(1, 0), b3, voffB); PG8_STAGE(PG8_SB(1, 1), b3 + hstep, voffB); PG8_STAGE(PG8_SA(1, 0), a3, voffA);
            PG8_WAIT_V(8); PG8_WAIT_L(0); PG8_BAR; PG8_MMA(1, 0, At, B0); PG8_MMA(1, 1, At, B1); PG8_BAR; PG8_SCHED;
            } else {
            PG8_LDB(B0, 0, 0); PG8_SCHED; PG8_LDA(At, 0, 0); PG8_STAGE(PG8_SA(1, 1), a1 + hstep, voffA);
            PG8_WAIT_L(8); PG8_BAR; PG8_WAIT_L(0); PG8_MMA(0, 0, At, B0); PG8_BAR; PG8_SCHED;
            PG8_LDB(B1, 0, 1); PG8_STAGE(PG8_SB(0, 0), b2, voffB);
            PG8_BAR; PG8_WAIT_L(0); PG8_MMA(0, 1, At, B1); PG8_BAR;
            PG8_LDA(At, 0, 1); PG8_STAGE(PG8_SA(0, 0), a2, voffA);
            PG8_BAR; PG8_WAIT_L(0); PG8_MMA(1, 0, At, B0); PG8_BAR; PG8_SCHED;
            PG8_STAGE(PG8_SB(0, 1), b2 + hstep, voffB);
            PG8_WAIT_V(6); PG8_BAR; PG8_MMA(1, 1, At, B1); PG8_BAR;
            PG8_LDB(B0, 1, 0); PG8_SCHED; PG8_LDA(At, 1, 0); PG8_STAGE(PG8_SA(0, 1), a2 + hstep, voffA);
            PG8_WAIT_L(8); PG8_BAR; PG8_WAIT_L(0); PG8_MMA(0, 0, At, B0); PG8_BAR; PG8_SCHED;
            PG8_LDB(B1, 1, 1); PG8_STAGE(PG8_SB(1, 0), b3, voffB);
            PG8_BAR; PG8_WAIT_L(0); PG8_MMA(0, 1, At, B1); PG8_BAR;
            PG8_LDA(At, 1, 1); PG8_STAGE(PG8_SA(1, 0), a3, voffA);
            PG8_BAR; PG8_WAIT_L(0); PG8_MMA(1, 0, At, B0); PG8_BAR; PG8_SCHED;
            PG8_STAGE(PG8_SB(1, 1), b3 + hstep, voffB);
            PG8_WAIT_V(6); PG8_BAR; PG8_MMA(1, 1, At, B1); PG8_BAR;
            }
        }
        if constexpr (ALIGN_EPI) { if (wr == 0) PG8_BAR; }
        if constexpr (!Epi::AFTER_DRAIN) { E(acc, cur, wr, wc, fr, fq); S.done(cur); }
        if (!has_next) break;
#pragma unroll
        for (int a = 0; a < 2; ++a)
#pragma unroll
            for (int b = 0; b < 2; ++b)
#pragma unroll
                for (int m = 0; m < 4; ++m)
#pragma unroll
                    for (int n = 0; n < 2; ++n) acc[a][b][m][n] = (f32x4){0.f, 0.f, 0.f, 0.f};
        cur = nxt; cA = nA; cB = nB; ++ui;
        if constexpr (ALIGN_EPI) { if (wr == 1) PG8_BAR; }
    }
    PG8_WAIT_V(0);
    if constexpr (!ALIGN_EPI) { if (wr == 0) PG8_BAR; }
    PG8_BAR;
    if constexpr (Epi::AFTER_DRAIN) { E.fused(acc, cur, wr, wc, fr, fq, lds, wid, lane); S.done(cur); }
#undef PG8_SA
#undef PG8_SB
#undef PG8_STAGE
#undef PG8_LDA
#undef PG8_LDB
#undef PG8_MMA
#undef PG8_WAIT_V
#undef PG8_WAIT_L
#undef PG8_BAR
#undef PG8_SCHED
}
}

using pg8::bf16_t; using pg8::bf16x8; using pg8::f32x4; using pg8::u32x4; using pg8::u32x2; using pg8::pk2; using pg8::f2bf; using pg8::bf2f;
#define LAS __attribute__((address_space(3)))
typedef short s16x4 __attribute__((ext_vector_type(4)));
typedef float f32x16 __attribute__((ext_vector_type(16)));
#define MFMA32(a, b, c) __builtin_amdgcn_mfma_f32_32x32x16_bf16((a), (b), (c), 0, 0, 0)
#define MFMA16(a, b, c) __builtin_amdgcn_mfma_f32_16x16x32_bf16((a), (b), (c), 0, 0, 0)
#define LDS_FENCE() asm volatile("s_waitcnt lgkmcnt(0)" ::: "memory")
#define DI __device__ __forceinline__
constexpr int NWAVES = 8, NTHREADS = 512;
constexpr int LDS_BYTES = 147456;
constexpr int WSCR = 8448;
constexpr int YG_OFF = NWAVES * WSCR;
constexpr int YG_LD = 520;

DI int crow(int reg, int h) { return (reg & 3) + 8 * (reg >> 2) + 4 * h; }
DI float sigmoidf_(float x) { return 1.0f / (1.0f + __expf(-x)); }
DI float siluf_(float x) { return x * sigmoidf_(x); }
DI float gelu_tanh(float y) { const float t = 0.7978845608028654f * (y + 0.044715f * y * y * y); const float th = 1.0f - 2.0f / (__expf(2.0f * t) + 1.0f); return 0.5f * y * (1.0f + th); }
DI float wave_sum(float v) {
#pragma unroll
    for (int o = 1; o < 64; o <<= 1) v += __shfl_xor(v, o);
    return v;
}
DI float wave_max(float v) {
#pragma unroll
    for (int o = 1; o < 64; o <<= 1) v = fmaxf(v, __shfl_xor(v, o));
    return v;
}
DI void sincos_d(double ang, float& s, float& c) {
    const double TWO_PI = 6.283185307179586476925, INV_TWO_PI = 0.15915494309189533576888;
    const double k = rint(ang * INV_TWO_PI);
    const double r = ang - k * TWO_PI, r2 = r * r;
    double ss = 1.0, cc = 1.0;
#pragma unroll
    for (int n = 15; n >= 1; --n) { ss = 1.0 - ss * r2 * (1.0 / ((2.0 * n) * (2.0 * n + 1.0))); cc = 1.0 - cc * r2 * (1.0 / ((2.0 * n - 1.0) * (2.0 * n))); }
    s = (float)(r * ss); c = (float)cc;
}

constexpr int PTR_OFF = 140 * 1024, XB_LDS_OFF = 140 * 1024 + 512;
constexpr size_t WS_XBAR = 512 * 1024;
struct Ctx { unsigned char* ws; float* out; LAS unsigned char* lds; int lane, wave, gw, ngw; };
#define GAS __attribute__((address_space(1)))
DI const GAS float* INP(const Ctx& X, int i) { const volatile LAS unsigned* p = (const volatile LAS unsigned*)(X.lds + PTR_OFF + 8 * i);
    const unsigned lo = __builtin_amdgcn_readfirstlane(p[0]), hi = __builtin_amdgcn_readfirstlane(p[1]); return (const GAS float*)(((unsigned long long)hi << 32) | lo); }
#define W_ROWSS(X) ((unsigned long long*)((X).ws + WS_ROWSS))
#define W_AB(X)    ((float2*)((X).ws + WS_AB))
#define W_AT(X)    ((float2*)((X).ws + WS_AT))
#define W_BB(X)    ((bf16_t*)((X).ws + WS_BB))
#define W_CC(X)    ((bf16_t*)((X).ws + WS_CC))
#define W_ROPE(X)  ((float2*)((X).ws + WS_ROPE))
#define W_WSB(X)   ((bf16_t*)((X).ws + WS_WSB))
#define W_WGT(X)   ((bf16_t*)((X).ws + WS_WGT))
#define W_WOT(X)   ((bf16_t*)((X).ws + WS_WOT))
#define W_WIT(X)   ((bf16_t*)((X).ws + WS_WIT))
#define W_XB(X)    ((bf16_t*)((X).ws + WS_XB))
#define W_XRES(X)  ((float*)((X).ws + WS_XRES))
#define W_Z(X)     ((bf16_t*)((X).ws + WS_Z))
#define W_MIX(X)   ((bf16_t*)((X).ws + WS_MIX))
#define W_VT(X)    ((bf16_t*)((X).ws + WS_VT))
#define W_VAT(X)   ((bf16_t*)((X).ws + WS_VAT))
#define W_E(X)     ((float2*)((X).ws + WS_E))
#define W_H0(X)    ((float2*)((X).ws + WS_H0))
enum { I_XP = 0, I_XS, I_CK, I_CV, I_SRE, I_SIM, I_NG, I_FG, I_WIN, I_WOUT, I_CW, I_CB, I_SINK, I_ARE, I_AIM, I_LDT, I_BRE, I_BIM, I_CRE, I_CIM, I_DSK, I_GW, I_GB };

DI void p0_transpose_item(const GAS float* W, const GAS float* gk, int K, int N, bf16_t* WT, LAS float* scr, int item, int lane) {
    const int nblk = N / 32, kb = item / nblk, nb = item % nblk, k0 = 64 * kb, n0 = 32 * nb;
    const int r8 = lane >> 3, c4 = (lane & 7) * 4;
#pragma unroll
    for (int i = 0; i < 8; ++i) { const int kk = 8 * i + r8; f32x4 v = *(const GAS f32x4*)(W + (size_t)(k0 + kk) * N + n0 + c4); if (gk) v = v * gk[k0 + kk];
        LAS float* d = scr + kk * 33 + c4; d[0] = v[0]; d[1] = v[1]; d[2] = v[2]; d[3] = v[3]; }
    LDS_FENCE();
    const int c = lane & 7;
#pragma unroll
    for (int j = 0; j < 4; ++j) { const int n = (lane >> 3) + 8 * j; const LAS float* s = scr + (8 * c) * 33 + n;
        u32x4 o; o.x = pk2(s[0 * 33], s[1 * 33]); o.y = pk2(s[2 * 33], s[3 * 33]); o.z = pk2(s[4 * 33], s[5 * 33]); o.w = pk2(s[6 * 33], s[7 * 33]);
        *(u32x4*)(WT + (size_t)(n0 + n) * K + k0 + 8 * c) = o; }
    LDS_FENCE();
}

DI void convert_layer_weights(const Ctx& X, int l, int w_id, int n_w) {
    LAS float* scr = (LAS float*)(X.lds + X.wave * WSCR);
    constexpr int I_IN = (DM / 64) * (DIN / 32), I_OUT = (DM / 64) * (DM / 32), I_G = (512 / 64) * (512 / 32), I_L = I_IN + I_OUT + I_G;
    const GAS float* w_in = INP(X, I_WIN); const GAS float* w_out = INP(X, I_WOUT); const GAS float* glu_w = INP(X, I_GW); const GAS float* norm_g = INP(X, I_NG);
    for (int it = w_id; it < I_L; it += n_w) {
        int r = it;
        if (r < I_IN) { p0_transpose_item(w_in + (size_t)l * DM * DIN, norm_g + l * DM, DM, DIN, W_WIT(X) + (size_t)l * DIN * DM, scr, r, X.lane); continue; } r -= I_IN;
        if (r < I_OUT) { p0_transpose_item(w_out + (size_t)l * DM * DM, nullptr, DM, DM, W_WOT(X) + (size_t)l * DM * DM, scr, r, X.lane); continue; } r -= I_OUT;
        p0_transpose_item(glu_w + (size_t)l * 512 * 512, nullptr, 512, 512, W_WGT(X) + (size_t)l * 512 * 512, scr, r, X.lane);
    }
}

DI void phase_prologue(const Ctx& X) {
    convert_layer_weights(X, 0, X.gw, X.ngw);
    if (gridDim.x < 16) { for (int l = 1; l < NLAYER; ++l) convert_layer_weights(X, l, X.gw, X.ngw); }
    { const GAS float* x_prompt = INP(X, I_XP); const GAS float* x_sample = INP(X, I_XS);
    for (int m = X.gw; m < MROWS; m += X.ngw) {
        const GAS float* xr = (m < 8192) ? (x_prompt + (size_t)m * DM) : (x_sample + (size_t)(m - 8192) * DM);
        float ss = 0.f;
#pragma unroll
        for (int j = 0; j < 8; ++j) { const f32x4 v = *(const GAS f32x4*)(xr + 4 * X.lane + 256 * j); ss += (v[0] * v[0] + v[1] * v[1]) + (v[2] * v[2] + v[3] * v[3]);
            u32x2 w; w.x = pk2(v[0], v[1]); w.y = pk2(v[2], v[3]); *(u32x2*)(W_XB(X) + (size_t)m * DM + 4 * X.lane + 256 * j) = w; }
        ss = wave_sum(ss);
        if (X.lane == 0) W_ROWSS(X)[m] = (unsigned long long)(ss * 4294967296.0f);
    } }
    const int gt = X.gw * 64 + X.lane, ngt = X.ngw * 64;
    { const GAS float* log_dt = INP(X, I_LDT); const GAS float* a_re = INP(X, I_ARE); const GAS float* a_im = INP(X, I_AIM); const GAS float* b_re = INP(X, I_BRE); const GAS float* b_im = INP(X, I_BIM);
      const GAS float* c_re = INP(X, I_CRE); const GAS float* c_im = INP(X, I_CIM);
    for (int i = gt; i < NLAYER * 32 * 64; i += ngt) {
        const int lg = i >> 6, p = i & 63;
        const float dt = expf(log_dt[lg]); const float ar = a_re[i], ai = a_im[i];
        float sn, cs; sincos_d((double)ai * (double)dt, sn, cs);
        const float mag = expf(ar * dt); const float abr = mag * cs, abi = mag * sn;
        W_AB(X)[i] = make_float2(abr, abi);
        float sn32, cs32; sincos_d((double)ai * (double)dt * 32.0, sn32, cs32);
        const float mag32 = expf(ar * dt * 32.0f);
        W_AT(X)[i] = make_float2(mag32 * cs32, mag32 * sn32);
        const float nr = abr - 1.0f, ni = abi, den = ar * ar + ai * ai;
        const float f_re = (nr * ar + ni * ai) / den, f_im = (ni * ar - nr * ai) / den;
        unsigned wr[8], wi[8];
#pragma unroll
        for (int c2 = 0; c2 < 8; ++c2) {
            const float br0 = b_re[(size_t)i * 16 + 2 * c2], bi0 = b_im[(size_t)i * 16 + 2 * c2], br1 = b_re[(size_t)i * 16 + 2 * c2 + 1], bi1 = b_im[(size_t)i * 16 + 2 * c2 + 1];
            wr[c2] = pk2(f_re * br0 - f_im * bi0, f_re * br1 - f_im * bi1);
            wi[c2] = pk2(f_re * bi0 + f_im * br0, f_re * bi1 + f_im * br1);
        }
        u32x4* rowr = (u32x4*)(W_BB(X) + ((size_t)lg * 128 + p) * 16); u32x4* rowi = (u32x4*)(W_BB(X) + ((size_t)lg * 128 + 64 + p) * 16);
        rowr[0] = (u32x4){wr[0], wr[1], wr[2], wr[3]}; rowr[1] = (u32x4){wr[4], wr[5], wr[6], wr[7]};
        rowi[0] = (u32x4){wi[0], wi[1], wi[2], wi[3]}; rowi[1] = (u32x4){wi[4], wi[5], wi[6], wi[7]};
    }
    for (int j = gt; j < NLAYER * 32 * 16 * 16; j += ngt) {
        const int kc = j & 15, lc = j >> 4, k0 = 8 * kc;
        const GAS float* src = (k0 < 64) ? (c_re + (size_t)lc * 64 + k0) : (c_im + (size_t)lc * 64 + (k0 - 64));
        const float sg = (k0 < 64) ? 1.0f : -1.0f;
        const f32x4 a0 = *(const GAS f32x4*)src, a1 = *(const GAS f32x4*)(src + 4);
        u32x4 w; w.x = pk2(sg * a0[0], sg * a0[1]); w.y = pk2(sg * a0[2], sg * a0[3]); w.z = pk2(sg * a1[0], sg * a1[1]); w.w = pk2(sg * a1[2], sg * a1[3]);
        *(u32x4*)(W_CC(X) + (size_t)lc * 128 + k0) = w;
    } }
    { const GAS float* chunk_w = INP(X, I_CW);
    for (int j = gt; j < NLAYER * 4 * 128 * 16; j += ngt) {
        const int t = (j >> 4) & 127, s0 = (j & 15) * 8;
        const f32x4 a0 = *(const GAS f32x4*)(chunk_w + (size_t)j * 8), a1 = *(const GAS f32x4*)(chunk_w + (size_t)j * 8 + 4);
        float v[8] = {a0[0], a0[1], a0[2], a0[3], a1[0], a1[1], a1[2], a1[3]};
#pragma unroll
        for (int e = 0; e < 8; ++e) v[e] = (s0 + e <= t) ? v[e] : 0.0f;
        u32x4 w; w.x = pk2(v[0], v[1]); w.y = pk2(v[2], v[3]); w.z = pk2(v[4], v[5]); w.w = pk2(v[6], v[7]);
        *(u32x4*)(W_WSB(X) + (size_t)j * 8) = w;
    } }
    for (int i = gt; i < 4104 * 8; i += ngt) {
        const int pi = i >> 3, j = i & 7;
        const double inv[8] = {1.0, 0.19392274474868576, 0.03760603093086393, 0.007292664737217109, 0.001414213562373095, 0.0002742481756762073, 5.318295896944988e-05, 1.031338537721246e-05};
        double iv = inv[0];
#pragma unroll
        for (int q = 1; q < 8; ++q) iv = (j == q) ? inv[q] : iv;
        const double pos = (pi < 4096) ? (double)pi : (double)(16384 + (pi - 4096));
        float sn, cs; sincos_d(pos * iv, sn, cs);
        W_ROPE(X)[i] = make_float2(cs, sn);
    }
}

DI float2 ld_e(const float2* p) { const unsigned long long v = __hip_atomic_load((const unsigned long long*)p, __ATOMIC_RELAXED, __HIP_MEMORY_SCOPE_SYSTEM); float2 r; r.x = __uint_as_float((unsigned)v); r.y = __uint_as_float((unsigned)(v >> 32)); return r; }
template <bool PASS_C>
DI void s5_wave_unit(const Ctx& X, int layer, int u, int slot, LAS float* bu, LAS bf16_t* yg) {
    const int lane = X.lane, r31 = lane & 31, h = lane >> 5;
    const int R0 = 32 * u; const bool samp = (u >= 256);
    const int b = u >> 7, chn = u & 127;
    const GAS float* st_re = INP(X, I_SRE); const GAS float* st_im = INP(X, I_SIM); const GAS float* dskip = INP(X, I_DSK);
    for (int gi = 0; gi < 4; ++gi) {
        const int g = 4 * slot + gi, lg = layer * 32 + g;
        const float2 ab = W_AB(X)[lg * 64 + lane];
        float hr = 0.f, hi = 0.f;
        if (PASS_C && !samp) { const float2 h0 = W_H0(X)[((size_t)(b * 128 + chn) * 32 + g) * 64 + lane]; hr = h0.x; hi = h0.y; }
        bf16x8 ua = *(const bf16x8*)(W_Z(X) + (size_t)(R0 + r31) * DIN + C_UC + 16 * g + 8 * h);
        bf16x8 bbf[4];
#pragma unroll
        for (int nt = 0; nt < 4; ++nt) bbf[nt] = *(const bf16x8*)(W_BB(X) + ((size_t)lg * 128 + 32 * nt + r31) * 16 + 8 * h);
        f32x16 acc[4];
#pragma unroll
        for (int nt = 0; nt < 4; ++nt) {
            f32x16 zz;
#pragma unroll
            for (int i = 0; i < 16; ++i) zz[i] = 0.f;
            asm volatile("" : "+v"(zz));
            acc[nt] = MFMA32(ua, bbf[nt], zz);
        }
        __builtin_amdgcn_sched_barrier(0);
        asm volatile("s_nop 15\n\ts_nop 15\n\ts_nop 15\n\ts_nop 15\n\ts_nop 15\n\ts_nop 15\n\ts_nop 15\n\ts_nop 15"
                     : "+v"(ua), "+v"(bbf[0]), "+v"(bbf[1]), "+v"(bbf[2]), "+v"(bbf[3]), "+v"(acc[0]), "+v"(acc[1]), "+v"(acc[2]), "+v"(acc[3]) :: "memory");
        __builtin_amdgcn_sched_barrier(0);
        bf16x8 cfrag[4];
        if (PASS_C) {
#pragma unroll
            for (int kk = 0; kk < 4; ++kk) cfrag[kk] = *(const bf16x8*)(W_CC(X) + ((size_t)lg * 16 + (lane & 15)) * 128 + 32 * kk + 8 * (lane >> 4));
        }
        const float dsk = PASS_C ? dskip[layer * 512 + 16 * g + (lane & 15)] : 0.f;
#pragma unroll
        for (int half = 0; half < 2; ++half) {
#pragma unroll
            for (int nt = 0; nt < 4; ++nt)
#pragma unroll
                for (int rr = 0; rr < 8; ++rr) bu[((rr & 3) + 8 * (rr >> 2) + 4 * h) * 132 + 32 * nt + r31] = acc[nt][8 * half + rr];
            LDS_FENCE();
            for (int tl = 0; tl < 16; ++tl) {
                const int t = 16 * half + tl;
                if (samp && (t & 7) == 0) { const size_t si = ((size_t)(layer * 32 + ((R0 - 8192 + t) >> 3)) * 32 + g) * 64 + lane; hr = st_re[si]; hi = st_im[si]; }
                const float br = bu[tl * 132 + lane], bi = bu[tl * 132 + 64 + lane];
                const float nr = ab.x * hr - ab.y * hi + br, ni = ab.x * hi + ab.y * hr + bi; hr = nr; hi = ni;
                if (PASS_C) {
                    LDS_FENCE();
                    LAS bf16_t* hs = (LAS bf16_t*)(bu + tl * 132); hs[lane] = f2bf(hr); hs[64 + lane] = f2bf(hi);
                    if (samp && (t & 7) == 7) { const size_t so = ((size_t)(layer * 32 + ((R0 - 8192 + t) >> 3)) * 32 + g) * 64 + lane; X.out[OFF_HRS + so] = hr; X.out[OFF_HIS + so] = hi; }
                }
            }
            LDS_FENCE();
            if (PASS_C) {
                f32x4 d = {0.f, 0.f, 0.f, 0.f}; asm volatile("" : "+v"(d));
#pragma unroll
                for (int kk = 0; kk < 4; ++kk) { const bf16x8 a = *(const LAS bf16x8*)((const LAS unsigned char*)bu + (lane & 15) * 528 + (32 * kk + 8 * (lane >> 4)) * 2); d = MFMA16(a, cfrag[kk], d); }
                __builtin_amdgcn_sched_barrier(0); asm volatile("s_nop 15\n\ts_nop 15\n\ts_nop 15" ::: "memory"); __builtin_amdgcn_sched_barrier(0);
                const int ch = 16 * g + (lane & 15);
#pragma unroll
                for (int reg = 0; reg < 4; ++reg) { const int t = 16 * half + 4 * (lane >> 4) + reg; const float uval = bf2f(W_Z(X)[(size_t)(R0 + t) * DIN + C_UC + ch]);
                    yg[t * YG_LD + ch] = f2bf(gelu_tanh(d[reg] + dsk * uval)); }
                LDS_FENCE();
            }
        }
        if (!PASS_C) { W_E(X)[((size_t)(b * 128 + chn) * 32 + g) * 64 + lane] = make_float2(hr, hi); }
        else if (!samp && chn == 127) { const size_t so = ((size_t)(layer * 2 + b) * 32 + g) * 64 + lane; X.out[OFF_HRP + so] = hr; X.out[OFF_HIP + so] = hi; }
    }
}

DI void phase_s5c(const Ctx& X, int layer, int u_first, int u_end) {
    LAS float* bu = (LAS float*)(X.lds + X.wave * WSCR);
    LAS bf16_t* yg = (LAS bf16_t*)(X.lds + YG_OFF);
    const int lane = X.lane, r31 = lane & 31, h = lane >> 5;
    const GAS float* glu_b = INP(X, I_GB);
    for (int u = u_first; u < u_end; u += gridDim.x) {
        s5_wave_unit<true>(X, layer, u, X.wave, bu, yg);
        LDS_FENCE(); __syncthreads();
        f32x16 ga[2];
#pragma unroll
        for (int nt = 0; nt < 2; ++nt)
#pragma unroll
            for (int i = 0; i < 16; ++i) ga[nt][i] = 0.f;
        asm volatile("" : "+v"(ga[0]), "+v"(ga[1]));
        const bf16_t* wg = W_WGT(X) + ((size_t)layer * 512 + 64 * X.wave + r31) * 512 + 8 * h;
#pragma unroll 1
        for (int kb = 0; kb < 4; ++kb) {
            bf16x8 af8[8], bf8[8][2];
#pragma unroll
            for (int k8 = 0; k8 < 8; ++k8) { const int ks = 8 * kb + k8; af8[k8] = *(const LAS bf16x8*)(yg + r31 * YG_LD + 16 * ks + 8 * h);
#pragma unroll
                for (int nt = 0; nt < 2; ++nt) bf8[k8][nt] = *(const bf16x8*)(wg + (size_t)nt * 32 * 512 + 16 * ks); }
#pragma unroll
            for (int k8 = 0; k8 < 8; ++k8)
#pragma unroll
                for (int nt = 0; nt < 2; ++nt) ga[nt] = MFMA32(af8[k8], bf8[k8][nt], ga[nt]);
            __builtin_amdgcn_sched_barrier(0); asm volatile("s_nop 15\n\ts_nop 15\n\ts_nop 15\n\ts_nop 15\n\ts_nop 15\n\ts_nop 15" ::: "memory"); __builtin_amdgcn_sched_barrier(0);
        }
        const int R0 = 32 * u;
#pragma unroll
        for (int nt = 0; nt < 2; ++nt) {
            const int n = 64 * X.wave + 32 * nt + r31; const float bg = glu_b[layer * 512 + n];
#pragma unroll
            for (int reg = 0; reg < 16; ++reg) { const int t = crow(reg, h); const size_t row = (size_t)(R0 + t);
                const float gate = sigmoidf_(ga[nt][reg] + bg); const float yv = bf2f(yg[t * YG_LD + n]); const float gc = bf2f(W_Z(X)[row * DIN + C_GC + n]);
                W_MIX(X)[row * DM + 1536 + n] = f2bf(yv * gate * siluf_(gc)); }
        }
        LDS_FENCE(); __syncthreads();
    }
}

DI void attn_item(const Ctx& X, int layer, int it) {
    const int lane = X.lane, r31 = lane & 31, h = lane >> 5;
    const int qt = it & 3, rr = (it >> 2) & 3, g = (it >> 4) & 3, blk = (it >> 6) & 31, b = it >> 11;
    const int head = 4 * g + rr, q0 = blk * 128 + 32 * qt, kbase = q0 - 128;
    const size_t rowb = (size_t)b * 4096;
    bf16x8 qf[4];
#pragma unroll
    for (int ks = 0; ks < 4; ++ks) qf[ks] = *(const bf16x8*)(W_Z(X) + (rowb + q0 + r31) * DIN + C_Q + 64 * head + 16 * ks + 8 * h);
    f32x16 S[5];
#pragma unroll
    for (int kb = 0; kb < 2; ++kb) {
        bf16x8 kf[3][4];
#pragma unroll
        for (int kk = 0; kk < 3; ++kk) { const int kt = 3 * kb + kk; if (kt < 5) {
            int tk = kbase + 32 * kt + r31; tk = tk < 0 ? 0 : tk;
            const bf16_t* kp = W_Z(X) + (rowb + tk) * DIN + C_K + 64 * g + 8 * h;
#pragma unroll
            for (int ks = 0; ks < 4; ++ks) kf[kk][ks] = *(const bf16x8*)(kp + 16 * ks); } }
#pragma unroll
        for (int kk = 0; kk < 3; ++kk) { const int kt = 3 * kb + kk; if (kt < 5) {
            f32x16 s;
#pragma unroll
            for (int i = 0; i < 16; ++i) s[i] = 0.f;
            asm volatile("" : "+v"(s));
#pragma unroll
            for (int ks = 0; ks < 4; ++ks) s = MFMA32(kf[kk][ks], qf[ks], s);
            S[kt] = s; } }
        __builtin_amdgcn_sched_barrier(0);
        asm volatile("s_nop 15\n\ts_nop 15\n\ts_nop 15\n\ts_nop 15\n\ts_nop 15\n\ts_nop 15\n\ts_nop 15\n\ts_nop 15" ::: "memory");
        __builtin_amdgcn_sched_barrier(0);
    }
    const float sink = INP(X, I_SINK)[layer * 16 + head];
    float m = sink;
#pragma unroll
    for (int kt = 0; kt < 5; ++kt)
#pragma unroll
        for (int reg = 0; reg < 16; ++reg) { const int jj = 32 * kt + crow(reg, h), dl = jj - r31; const bool ok = (dl >= 1) && (dl <= 128) && (kbase + jj >= 0);
            const float s = ok ? S[kt][reg] * 0.125f : -1e30f; S[kt][reg] = s; m = fmaxf(m, s); }
    m = fmaxf(m, __shfl_xor(m, 32));
    float sum = 0.f;
#pragma unroll
    for (int kt = 0; kt < 5; ++kt)
#pragma unroll
        for (int reg = 0; reg < 16; ++reg) { const float p = __expf(S[kt][reg] - m); S[kt][reg] = p; sum += p; }
    sum += __shfl_xor(sum, 32); sum += __expf(sink - m);
    const float inv = 1.0f / sum;
    f32x16 O[2];
#pragma unroll
    for (int dt = 0; dt < 2; ++dt)
#pragma unroll
        for (int i = 0; i < 16; ++i) O[dt][i] = 0.f;
    asm volatile("" : "+v"(O[0]), "+v"(O[1]));
#pragma unroll
    for (int kt = 0; kt < 5; ++kt)
#pragma unroll
        for (int s2 = 0; s2 < 2; ++s2) {
            u32x4 pw; pw.x = pk2(S[kt][8 * s2 + 0], S[kt][8 * s2 + 1]); pw.y = pk2(S[kt][8 * s2 + 2], S[kt][8 * s2 + 3]); pw.z = pk2(S[kt][8 * s2 + 4], S[kt][8 * s2 + 5]); pw.w = pk2(S[kt][8 * s2 + 6], S[kt][8 * s2 + 7]);
            const bf16x8 pf = __builtin_bit_cast(bf16x8, pw);
            const int tk = kbase + 32 * kt + 16 * s2 + 4 * h; const int t0 = tk < 0 ? 0 : tk, t1 = (tk + 8) < 0 ? 0 : (tk + 8);
            s16x4 vlo[2], vhi[2];
#pragma unroll
            for (int dt = 0; dt < 2; ++dt) { const bf16_t* vp = W_VT(X) + ((size_t)((b * 4 + g) * 64 + 32 * dt + r31)) * 4096; vlo[dt] = *(const s16x4*)(vp + t0); vhi[dt] = *(const s16x4*)(vp + t1); }
#pragma unroll
            for (int dt = 0; dt < 2; ++dt) {
                const bf16x8 vf = __builtin_shufflevector(vlo[dt], vhi[dt], 0, 1, 2, 3, 4, 5, 6, 7);
                O[dt] = MFMA32(vf, pf, O[dt]);
            }
            __builtin_amdgcn_sched_barrier(0); asm volatile("s_nop 15\n\ts_nop 15\n\ts_nop 15\n\ts_nop 15" ::: "memory"); __builtin_amdgcn_sched_barrier(0);
        }
    const size_t rq = rowb + q0 + r31;
#pragma unroll
    for (int dt = 0; dt < 2; ++dt)
#pragma unroll
        for (int rg = 0; rg < 4; ++rg) {
            const int d0 = 32 * dt + 8 * rg + 4 * h;
            const u32x2 gw2 = *(const u32x2*)(W_Z(X) + rq * DIN + C_GB + 64 * head + d0);
            const float g0 = __uint_as_float(gw2.x << 16), g1 = __uint_as_float(gw2.x & 0xffff0000u), g2 = __uint_as_float(gw2.y << 16), g3 = __uint_as_float(gw2.y & 0xffff0000u);
            u32x2 w; w.x = pk2(O[dt][4 * rg + 0] * inv * siluf_(g0), O[dt][4 * rg + 1] * inv * siluf_(g1)); w.y = pk2(O[dt][4 * rg + 2] * inv * siluf_(g2), O[dt][4 * rg + 3] * inv * siluf_(g3));
            *(u32x2*)(W_MIX(X) + rq * DM + 512 + 64 * head + d0) = w;
        }
}

DI void chunk_item(const Ctx& X, int layer, int it) {
    const int lane = X.lane, r31 = lane & 31, h = lane >> 5;
    const int sub = it & 7, hh = (it >> 3) & 3, chunk = it >> 5, ct = sub & 3, th = sub >> 2;
    const GAS float* chunk_b = INP(X, I_CB);
    const bf16_t* ap = W_VAT(X) + ((size_t)(128 * hh + 32 * ct + r31)) * 8192 + chunk * 128 + 8 * h;
    bf16x8 af[8];
#pragma unroll
    for (int ks = 0; ks < 8; ++ks) af[ks] = *(const bf16x8*)(ap + 16 * ks);
#pragma unroll
    for (int t2 = 0; t2 < 2; ++t2) {
        const int tt = 2 * th + t2, t = 32 * tt + r31;
        const bf16_t* bp = W_WSB(X) + ((size_t)((layer * 4 + hh) * 128 + t)) * 128 + 8 * h;
        f32x16 d;
#pragma unroll
        for (int i = 0; i < 16; ++i) d[i] = 0.f;
        asm volatile("" : "+v"(d));
#pragma unroll
        for (int ks = 0; ks < 8; ++ks) if (ks < 2 * (tt + 1)) d = MFMA32(af[ks], *(const bf16x8*)(bp + 16 * ks), d);
        __builtin_amdgcn_sched_barrier(0); asm volatile("s_nop 15\n\ts_nop 15\n\ts_nop 15\n\ts_nop 15\n\ts_nop 15\n\ts_nop 15" ::: "memory"); __builtin_amdgcn_sched_barrier(0);
        const size_t row = (size_t)chunk * 128 + t; const float bs = chunk_b[(layer * 4 + hh) * 128 + t];
#pragma unroll
        for (int rg = 0; rg < 4; ++rg) {
            const int c0 = 128 * hh + 32 * ct + 8 * rg + 4 * h;
            const u32x2 uw = *(const u32x2*)(W_Z(X) + row * DIN + C_UA + c0), gw2 = *(const u32x2*)(W_Z(X) + row * DIN + C_GA + c0);
            const float u0 = __uint_as_float(uw.x << 16), u1 = __uint_as_float(uw.x & 0xffff0000u), u2 = __uint_as_float(uw.y << 16), u3 = __uint_as_float(uw.y & 0xffff0000u);
            const float g0 = __uint_as_float(gw2.x << 16), g1 = __uint_as_float(gw2.x & 0xffff0000u), g2 = __uint_as_float(gw2.y << 16), g3 = __uint_as_float(gw2.y & 0xffff0000u);
            u32x2 w; w.x = pk2(u0 * (d[4 * rg + 0] + bs) * siluf_(g0), u1 * (d[4 * rg + 1] + bs) * siluf_(g1)); w.y = pk2(u2 * (d[4 * rg + 2] + bs) * siluf_(g2), u3 * (d[4 * rg + 3] + bs) * siluf_(g3));
            *(u32x2*)(W_MIX(X) + row * DM + c0) = w;
        }
    }
}

DI void sample_chunk_item(const Ctx& X, int layer, int it) {
    const int lane = X.lane, seq = it >> 2, hh = it & 3;
    const size_t row0 = 8192 + (size_t)seq * 8;
    const GAS float* chunk_b = INP(X, I_CB); const GAS float* chunk_w = INP(X, I_CW);
#pragma unroll
    for (int cpass = 0; cpass < 2; ++cpass) {
        const int ch = 128 * hh + 64 * cpass + lane;
        float va[8];
#pragma unroll
        for (int s = 0; s < 8; ++s) va[s] = bf2f(W_Z(X)[(row0 + s) * DIN + C_VA + ch]);
#pragma unroll
        for (int t = 0; t < 8; ++t) {
            float a = chunk_b[(layer * 4 + hh) * 128 + t];
#pragma unroll
            for (int s = 0; s < 8; ++s) if (s <= t) a += chunk_w[((size_t)((layer * 4 + hh) * 128 + t)) * 128 + s] * va[s];
            const float uu = bf2f(W_Z(X)[(row0 + t) * DIN + C_UA + ch]), gg = bf2f(W_Z(X)[(row0 + t) * DIN + C_GA + ch]);
            W_MIX(X)[(row0 + t) * DM + ch] = f2bf(uu * a * siluf_(gg));
        }
    }
}

DI void sample_attn_item(const Ctx& X, int layer, int it, LAS float* scr) {
    const int lane = X.lane, seq = it >> 4, head = it & 15, g = head >> 2;
    const size_t row0 = 8192 + (size_t)seq * 8;
    LAS float* Q = scr; LAS float* P = scr + 512;
    const bf16_t* z = W_Z(X);
#pragma unroll
    for (int i = 0; i < 8; ++i) Q[i * 64 + lane] = bf2f(z[(row0 + i) * DIN + C_Q + 64 * head + lane]) * 0.125f;
    LDS_FENCE();
    const float sink = INP(X, I_SINK)[layer * 16 + head];
    const GAS float* cache_k = INP(X, I_CK);
#pragma unroll 1
    for (int rd = 0; rd < 3; ++rd) {
        const int j = 64 * rd + lane;
        float kv[64];
        if (rd < 2) {
            const GAS float* kp = cache_k + (((size_t)(layer * 32 + seq) * 128 + j) * 4 + g) * 64;
#pragma unroll
            for (int d4 = 0; d4 < 16; ++d4) { const f32x4 v = *(const GAS f32x4*)(kp + 4 * d4); kv[4 * d4] = v[0]; kv[4 * d4 + 1] = v[1]; kv[4 * d4 + 2] = v[2]; kv[4 * d4 + 3] = v[3]; }
        } else {
            const int jn = (lane < 8) ? lane : 0;
            const bf16_t* kp = z + (row0 + jn) * DIN + C_K + 64 * g;
#pragma unroll
            for (int d8 = 0; d8 < 8; ++d8) { const u32x4 w = *(const u32x4*)(kp + 8 * d8);
#pragma unroll
                for (int e = 0; e < 4; ++e) { kv[8 * d8 + 2 * e] = __uint_as_float(w[e] << 16); kv[8 * d8 + 2 * e + 1] = __uint_as_float(w[e] & 0xffff0000u); } }
        }
#pragma unroll
        for (int i = 0; i < 8; ++i) {
            float a = 0.f;
#pragma unroll
            for (int d4 = 0; d4 < 16; ++d4) { const f32x4 q = *(const LAS f32x4*)(Q + i * 64 + 4 * d4); a += q[0] * kv[4 * d4] + q[1] * kv[4 * d4 + 1] + q[2] * kv[4 * d4 + 2] + q[3] * kv[4 * d4 + 3]; }
            const int dl = j - i; const bool ok = (j < 136) && (dl >= 1) && (dl <= 128);
            if (j < 136) P[j * 8 + i] = ok ? a : -1e30f;
        }
    }
    LDS_FENCE();
    float inv[8];
#pragma unroll
    for (int i = 0; i < 8; ++i) {
        const float s0 = P[lane * 8 + i], s1 = P[(64 + lane) * 8 + i], s2 = (lane < 8) ? P[(128 + lane) * 8 + i] : -1e30f;
        const float m = fmaxf(wave_max(fmaxf(fmaxf(s0, s1), s2)), sink);
        const float p0 = __expf(s0 - m), p1 = __expf(s1 - m), p2 = (lane < 8) ? __expf(s2 - m) : 0.f;
        inv[i] = 1.0f / (wave_sum(p0 + p1 + p2) + __expf(sink - m));
        P[lane * 8 + i] = p0; P[(64 + lane) * 8 + i] = p1; if (lane < 8) P[(128 + lane) * 8 + i] = p2;
    }
    LDS_FENCE();
    float o[8];
#pragma unroll
    for (int i = 0; i < 8; ++i) o[i] = 0.f;
    const GAS float* vp = INP(X, I_CV) + (((size_t)(layer * 32 + seq) * 128) * 4 + g) * 64 + lane;
#pragma unroll 16
    for (int j = 0; j < 128; ++j) { const float v = vp[(size_t)j * 256]; const f32x4 p0 = *(const LAS f32x4*)(P + j * 8), p1 = *(const LAS f32x4*)(P + j * 8 + 4);
        o[0] += p0[0] * v; o[1] += p0[1] * v; o[2] += p0[2] * v; o[3] += p0[3] * v; o[4] += p1[0] * v; o[5] += p1[1] * v; o[6] += p1[2] * v; o[7] += p1[3] * v; }
#pragma unroll
    for (int jn = 0; jn < 8; ++jn) { const float v = bf2f(z[(row0 + jn) * DIN + C_V + 64 * g + lane]); const f32x4 p0 = *(const LAS f32x4*)(P + (128 + jn) * 8), p1 = *(const LAS f32x4*)(P + (128 + jn) * 8 + 4);
        o[0] += p0[0] * v; o[1] += p0[1] * v; o[2] += p0[2] * v; o[3] += p0[3] * v; o[4] += p1[0] * v; o[5] += p1[1] * v; o[6] += p1[2] * v; o[7] += p1[3] * v; }
#pragma unroll
    for (int i = 0; i < 8; ++i) { const float gb = bf2f(z[(row0 + i) * DIN + C_GB + 64 * head + lane]); W_MIX(X)[(row0 + i) * DM + 512 + 64 * head + lane] = f2bf(o[i] * inv[i] * siluf_(gb)); }
    LDS_FENCE();
}

DI void phase_mixA(const Ctx& X, int layer) {
    LAS float* scr = (LAS float*)(X.lds + X.wave * WSCR);
    constexpr int N_ATT = 4096, N_CH = 2048, N_SA = 512, N_SC = 128, N_S5 = 2048;
    for (int it = X.gw; it < N_S5; it += X.ngw) s5_wave_unit<false>(X, layer, it >> 3, it & 7, scr, nullptr);
    for (int it = X.gw; it < N_SA; it += X.ngw) sample_attn_item(X, layer, it, scr);
    for (int it = X.gw; it < N_SC; it += X.ngw) sample_chunk_item(X, layer, it);
    if (gridDim.x >= 72 && blockIdx.x >= 64 && blockIdx.x < 72) { asm volatile("s_waitcnt vmcnt(0) lgkmcnt(0)" ::: "memory"); __syncthreads(); phase_s5c(X, layer, 256 + (int)blockIdx.x - 64, 264); }
    else if (gridDim.x < 72) { asm volatile("s_waitcnt vmcnt(0) lgkmcnt(0)" ::: "memory"); __syncthreads(); phase_s5c(X, layer, 256 + (int)blockIdx.x, 264); }
}

DI void phase_carry(const Ctx& X, int layer) {
    const int lane = X.lane;
    for (int it = X.gw; it < 64; it += X.ngw) {
        const int b = it >> 5, g = it & 31, lg = layer * 32 + g;
        const float2 aT = W_AT(X)[lg * 64 + lane];
        const float2* Ep = W_E(X) + ((size_t)(b * 128) * 32 + g) * 64 + lane;
        float2* Hp = W_H0(X) + ((size_t)(b * 128) * 32 + g) * 64 + lane;
        float hr = 0.f, hi = 0.f;
        for (int c = 0; c < 128; c += 16) {
            float2 e[16];
#pragma unroll
            for (int j = 0; j < 16; ++j) e[j] = Ep[(size_t)(c + j) * 2048];
#pragma unroll
            for (int j = 0; j < 16; ++j) { Hp[(size_t)(c + j) * 2048] = make_float2(hr, hi); const float nr = aT.x * hr - aT.y * hi + e[j].x, ni = aT.x * hi + aT.y * hr + e[j].y; hr = nr; hi = ni; }
        }
    }
}

DI void phase_final(const Ctx& X) {
    const GAS float* final_g = INP(X, I_FG);
    for (int m = X.gw; m < MROWS; m += X.ngw) {
        const float rs = rsqrtf((float)W_ROWSS(X)[4 * MROWS + m] * (2.3283064365386963e-10f / 2048.0f) + 1e-5f);
#pragma unroll
        for (int j = 0; j < 8; ++j) { const int c = 4 * X.lane + 256 * j; const f32x4 v = *(const f32x4*)(W_XRES(X) + (size_t)m * DM + c); const f32x4 gg = *(const GAS f32x4*)(final_g + c);
            *(f32x4*)(X.out + OFF_Y + (size_t)m * DM + c) = v * rs * gg; }
    }
}

#define XB_TMO      128
#define XB_XCNT(j)  (256  + 64 * (j))
#define XB_XSUB(j)  (1280 + 64 * (j))
#define XB_XGEN(j)  (2304 + 64 * (j))
#define XB_TOP      3328
#define XB_TOPGEN   3392
#define XCD_BAR_WORDS 3456
#define XB_SPIN_CAP (1u << 18)

__device__ __forceinline__ unsigned xb_ld(unsigned* p)              { return __hip_atomic_load(p, __ATOMIC_RELAXED, __HIP_MEMORY_SCOPE_AGENT); }
__device__ __forceinline__ unsigned xb_add(unsigned* p, unsigned v) { return __hip_atomic_fetch_add(p, v, __ATOMIC_RELAXED, __HIP_MEMORY_SCOPE_AGENT); }
__device__ __forceinline__ unsigned xb_xcc_id() { return (unsigned)__builtin_amdgcn_s_getreg((3 << 11) | 20) & 0xFu; }
#define XB_SPIN(cond, bar) do { unsigned _sp = 0; while (cond) { __builtin_amdgcn_s_sleep(1); \
    if ((++_sp & 255u) == 0u) { if (xb_ld(&(bar)[XB_TMO])) break; if (_sp > XB_SPIN_CAP) { atomicAdd(&(bar)[XB_TMO], 1u); break; } } } } while (0)

struct XcdBarrier {
    unsigned* bar; unsigned x;
    volatile LAS unsigned* st;
};

__device__ __forceinline__ XcdBarrier xcd_barrier_post(unsigned* bar, volatile LAS unsigned* st) {
    XcdBarrier b; b.bar = bar; b.x = xb_xcc_id(); b.st = st;
    if (threadIdx.x == 0) (void)xb_add(&bar[XB_XCNT(b.x)], 1u);
    return b;
}
__device__ __forceinline__ void xcd_barrier_complete(unsigned* bar, unsigned x, unsigned& nloc, unsigned& nx) {
    const unsigned G = gridDim.x * gridDim.y * gridDim.z;
    unsigned sum, cnt, mine, sp = 0u;
    for (;;) {
        sum = 0u; cnt = 0u; mine = 0u;
#pragma unroll
        for (unsigned j = 0; j < 16; ++j) { const unsigned c = xb_ld(&bar[XB_XCNT(j)]); sum += c; cnt += (c > 0u) ? 1u : 0u; mine = (j == x) ? c : mine; }
        if (sum == G) break;
        __builtin_amdgcn_s_sleep(1);
        if ((++sp & 255u) == 0u) { if (xb_ld(&bar[XB_TMO])) break; if (sp > XB_SPIN_CAP) { atomicAdd(&bar[XB_TMO], 1u); break; } }
    }
    nloc = mine > 0u ? mine : 1u; nx = cnt > 0u ? cnt : 1u;
}

__device__ __forceinline__ void xcd_barrier(const XcdBarrier& b) {
    asm volatile("s_waitcnt vmcnt(0)" ::: "memory");
    __syncthreads();
    if (threadIdx.x == 0) {
        unsigned* bar = b.bar;
        __builtin_amdgcn_s_waitcnt(0);
        unsigned nloc = b.st[0], nx = b.st[1];
        if (nloc == 0u) { xcd_barrier_complete(bar, b.x, nloc, nx); b.st[0] = nloc; b.st[1] = nx; }
        const unsigned old = xb_add(&bar[XB_XSUB(b.x)], 1u);
        const unsigned gen = old / nloc;
        if (old + 1u == (gen + 1u) * nloc) {
            __builtin_amdgcn_fence(__ATOMIC_RELEASE, "agent");
            asm volatile("s_waitcnt vmcnt(0)" ::: "memory");
            const unsigned og = xb_add(&bar[XB_TOP], 1u);
            const unsigned tg = og / nx;
            if (og + 1u == (tg + 1u) * nx) xb_add(&bar[XB_TOPGEN], 1u);
            else XB_SPIN(xb_ld(&bar[XB_TOPGEN]) == tg, bar);
            __builtin_amdgcn_fence(__ATOMIC_ACQUIRE, "agent");
            xb_add(&bar[XB_XGEN(b.x)], 1u);
            asm volatile("s_waitcnt vmcnt(0)" ::: "memory");
        } else {
            XB_SPIN(xb_ld(&bar[XB_XGEN(b.x)]) == gen, bar);
            __builtin_amdgcn_fence(__ATOMIC_ACQUIRE, "agent");
            asm volatile("s_waitcnt vmcnt(0)" ::: "memory");
        }
    }
    __syncthreads();
}

struct Args { const float* in[23]; float* out; unsigned char* ws; int ph_lo, ph_hi; };
constexpr int N_PHASES = 2 + 5 * NLAYER;

__global__ void __launch_bounds__(NTHREADS, 2) fwd_megakernel(Args a) {
    extern __shared__ __attribute__((aligned(16))) unsigned char lds_raw[];
    Ctx X0;
    X0.lds = (LAS unsigned char*)lds_raw;
    X0.lane = threadIdx.x & 63; X0.wave = __builtin_amdgcn_readfirstlane(threadIdx.x >> 6);
    X0.gw = blockIdx.x * NWAVES + X0.wave; X0.ngw = gridDim.x * NWAVES;
    X0.out = a.out; X0.ws = a.ws;
    if (threadIdx.x < 23) *(LAS unsigned long long*)(X0.lds + PTR_OFF + 8 * threadIdx.x) = (unsigned long long)a.in[threadIdx.x];
    if (threadIdx.x == 0) { *(volatile LAS unsigned*)(X0.lds + XB_LDS_OFF) = 0u; *(volatile LAS unsigned*)(X0.lds + XB_LDS_OFF + 4) = 0u; }
    LDS_FENCE(); __syncthreads();
    XcdBarrier xbar = xcd_barrier_post((unsigned*)(a.ws + WS_XBAR), (volatile LAS unsigned*)(X0.lds + XB_LDS_OFF));

    for (int ph = a.ph_lo; ph < a.ph_hi; ++ph) {
        if (ph > a.ph_lo) {
            if (ph == a.ph_lo + 1) {
                asm volatile("s_waitcnt vmcnt(0) lgkmcnt(0)" ::: "memory");
                __builtin_amdgcn_fence(__ATOMIC_RELEASE, "agent");
                asm volatile("s_waitcnt vmcnt(0)" ::: "memory");
                __syncthreads();
                cg::this_grid().sync();
                __builtin_amdgcn_fence(__ATOMIC_ACQUIRE, "agent");
                asm volatile("s_waitcnt vmcnt(0)" ::: "memory");
                __syncthreads();
            } else {
                asm volatile("s_waitcnt vmcnt(0) lgkmcnt(0)" ::: "memory");
                xcd_barrier(xbar);
            }
        } else { __builtin_amdgcn_fence(__ATOMIC_ACQUIRE, "agent"); asm volatile("s_waitcnt vmcnt(0)" ::: "memory"); __syncthreads(); }
        Ctx X = X0;
        asm volatile("" : "+v"(X.lane), "+s"(X.wave), "+s"(X.gw), "+s"(X.ngw));
        if (ph == 100) { for (int i = X.gw * 64 + X.lane; i < MROWS * 512; i += X.ngw * 64) X.out[i] = bf2f(W_Z(X)[(size_t)(i >> 9) * DIN + C_UC + (i & 511)]); }
        else if (ph == 101) { for (int i = X.gw * 64 + X.lane; i < 2 * 128 * 32 * 64 * 2; i += X.ngw * 64) X.out[8 * 1024 * 1024 + i] = ((const float*)W_E(X))[i]; }
        else if (ph == 0) phase_prologue(X);
        else if (ph == N_PHASES - 1) phase_final(X);
        else {
            const int l = (ph - 1) / 5, k = (ph - 1) % 5;
            if (k == 0) {
                pg8::Gemm g{W_XB(X), W_WIT(X) + (size_t)l * DIN * DM, MROWS, DIN, DM}; pg8::StaticOrder S; S.init(MROWS, DIN, (int)gridDim.x, (int)blockIdx.x);
                pg8::EpiIn E{X.ws, X.out, l};
                pg8::gemm_phase<pg8::EpiIn, pg8::StaticOrder, true, true>(X.lds, g, S, E);
            } else if (k == 1) phase_mixA(X, l);
            else if (k == 2) {
                phase_carry(X, l);
                if (X.ngw == 2048) {
                    if (X.gw < 1984) { attn_item(X, l, X.gw); attn_item(X, l, X.gw + 1984); if (X.gw >= 1000 && X.gw < 1128) attn_item(X, l, 3968 + X.gw - 1000); }
                } else for (int it = X.gw; it < 4096; it += X.ngw) attn_item(X, l, it);
                for (int it = X.gw; it < 2048; it += X.ngw) chunk_item(X, l, it);
                if (gridDim.x >= 16 && blockIdx.x < gridDim.x - 8 && l + 1 < NLAYER) { asm volatile("s_waitcnt vmcnt(0) lgkmcnt(0)" ::: "memory"); convert_layer_weights(X, l + 1, X.gw, (int)(gridDim.x - 8) * NWAVES); }
                if (gridDim.x >= 16 && blockIdx.x >= gridDim.x - 8) {
                    asm volatile("s_waitcnt vmcnt(0) lgkmcnt(0)" ::: "memory"); __syncthreads();
                    pg8::Gemm g{W_MIX(X), W_WOT(X) + (size_t)l * DM * DM, MROWS, DM, DM}; pg8::SampleOrder S{(int)blockIdx.x, (int)gridDim.x};
                    pg8::EpiOut E{l == 0 ? (const float*)INP(X, I_XP) : (const float*)W_XRES(X), l == 0 ? (const float*)INP(X, I_XS) : (const float*)(W_XRES(X) + (size_t)8192 * DM), X.ws, l};
                    pg8::gemm_phase<pg8::EpiOut, pg8::SampleOrder, true, true>(X.lds, g, S, E);
                }
            }
            else if (k == 3) phase_s5c(X, l, (int)blockIdx.x, 256);
            else {
                pg8::Gemm g{W_MIX(X), W_WOT(X) + (size_t)l * DM * DM, MROWS, DM, DM}; pg8::StaticOrder S; S.init(gridDim.x >= 16 ? MPROMPT : MROWS, DM, (int)gridDim.x, (int)blockIdx.x);
                pg8::EpiOut E{l == 0 ? (const float*)INP(X, I_XP) : (const float*)W_XRES(X), l == 0 ? (const float*)INP(X, I_XS) : (const float*)(W_XRES(X) + (size_t)8192 * DM), X.ws, l};
                pg8::gemm_phase<pg8::EpiOut, pg8::StaticOrder, true, true>(X.lds, g, S, E);
            }
        }
    }
    asm volatile("s_waitcnt vmcnt(0)" ::: "memory"); __builtin_amdgcn_fence(__ATOMIC_RELEASE, "agent"); asm volatile("s_waitcnt vmcnt(0)" ::: "memory");
}

extern "C" void kernel_launch(void* const* d_in, const int* in_sizes, int n_in, void* d_out, int out_size, void* d_ws, size_t ws_size, hipStream_t stream) {
    static int grid = 0;
    if (grid == 0) {
        if (n_in != 23 || (size_t)out_size != OUT_TOTAL || ws_size < WS_END) { fprintf(stderr, "kernel_launch: unexpected shapes (n_in %d, out %d, ws %zu); nothing launched\n", n_in, out_size, ws_size); grid = -1; return; }
        int dev = 0, cus = 0, per_cu = 0;
        if (hipGetDevice(&dev) != hipSuccess || hipDeviceGetAttribute(&cus, hipDeviceAttributeMultiprocessorCount, dev) != hipSuccess) { grid = -1; return; }
        if (hipFuncSetAttribute((const void*)fwd_megakernel, hipFuncAttributeMaxDynamicSharedMemorySize, LDS_BYTES) != hipSuccess) { fprintf(stderr, "kernel_launch: hipFuncSetAttribute failed\n"); grid = -1; return; }
        if (hipOccupancyMaxActiveBlocksPerMultiprocessor(&per_cu, (const void*)fwd_megakernel, NTHREADS, LDS_BYTES) != hipSuccess || per_cu < 1) { fprintf(stderr, "kernel_launch: occupancy query says %d blocks/CU\n", per_cu); per_cu = 1; }
        (void)hipGetLastError();
        grid = cus;
    }
    if (grid < 0) return;
    if (hipMemsetAsync((char*)d_ws + WS_CTL, 0, CTL_ZERO_BYTES, stream) != hipSuccess) { fprintf(stderr, "kernel_launch: memset failed\n"); return; }
    Args a{};
    for (int i = 0; i < 23; ++i) a.in[i] = (const float*)d_in[i];
    a.out = (float*)d_out; a.ws = (unsigned char*)d_ws;
#if N_LAUNCH_MODE == 1
    a.ph_lo = 0; a.ph_hi = N_PHASES;
    void* args[] = {&a};
    hipError_t e = hipLaunchCooperativeKernel((const void*)fwd_megakernel, dim3(grid), dim3(NTHREADS), args, LDS_BYTES, stream);
    if (e != hipSuccess) fprintf(stderr, "kernel_launch: cooperative launch failed: %s (grid %d)\n", hipGetErrorString(e), grid);
#else
#ifndef DBG_MAX_PH
#define DBG_MAX_PH N_PHASES
#endif
    for (int ph = 0; ph < DBG_MAX_PH; ++ph) {
        a.ph_lo = ph; a.ph_hi = ph + 1;
        hipLaunchKernelGGL(fwd_megakernel, dim3(grid), dim3(NTHREADS), LDS_BYTES, stream, a);
    }
#ifdef DBG_DUMP
    a.ph_lo = DBG_DUMP; a.ph_hi = DBG_DUMP + 1; hipLaunchKernelGGL(fwd_megakernel, dim3(grid), dim3(NTHREADS), LDS_BYTES, stream, a);
#endif
#endif
}
```

```cpp
#include <hip/hip_runtime.h>
#include <hip/hip_cooperative_groups.h>
#include <cstdio>
#include <cstdint>
namespace cg = cooperative_groups;

#ifndef N_LAUNCH_MODE
#define N_LAUNCH_MODE 1
#endif

constexpr int DM = 2048, DIN = 5120, MROWS = 8448, MPROMPT = 8192, NLAYER = 4;
constexpr int C_UA = 0, C_VA = 512, C_GA = 1024, C_Q = 1536, C_K = 2560, C_V = 2816, C_GB = 3072, C_UC = 4096, C_GC = 4608;
constexpr size_t OFF_Y = 0, OFF_KP = 17301504, OFF_VP = 17563648, OFF_KS = 17825792, OFF_VS = 18087936,
                 OFF_HRP = 18350080, OFF_HIP = 18366464, OFF_HRS = 18382848, OFF_HIS = 18644992, OFF_VA = 18907136, OUT_TOTAL = 19431424;
constexpr size_t MiB = 1u << 20;
constexpr size_t WS_CTL = 0, CTL_ZERO_BYTES = 1 * MiB, WS_ROWSS = 65536;
constexpr size_t WS_AB = 1 * MiB, WS_AT = WS_AB + 65536, WS_BB = WS_AT + 65536, WS_CC = WS_BB + 524288, WS_ROPE = WS_CC + 524288, WS_WSB = WS_ROPE + 262656 + 1472  ;
constexpr size_t WS_WGT = 4 * MiB, WS_WOT = 6 * MiB, WS_WIT = 38 * MiB, WS_XB = 118 * MiB, WS_XRES = 151 * MiB, WS_Z = 217 * MiB,
                 WS_MIX = 300 * MiB, WS_VT = 333 * MiB, WS_VAT = 337 * MiB, WS_E = 345 * MiB, WS_H0 = 349 * MiB, WS_END = 353 * MiB;
static_assert(WS_WSB + 524288 <= WS_WGT, "tables fit");
static_assert(WS_WSB % 16 == 0, "align");

namespace pg8 {
#define PG8_LAS __attribute__((address_space(3)))
typedef unsigned short bf16_t;
typedef short bf16x8 __attribute__((ext_vector_type(8)));
typedef float f32x4 __attribute__((ext_vector_type(4)));
typedef unsigned u32x4 __attribute__((ext_vector_type(4)));
typedef unsigned u32x2 __attribute__((ext_vector_type(2)));
constexpr int BM = 256, BK = 64, HALF = 128, HTB = HALF * BK * 2  , STAGE_BYTES = 8 * HTB, NXCD = 8, WGM = 8;
__host__ __device__ __forceinline__ int lds_byte(int r, int c) { const int st = (r >> 4) * 2 + (c >> 5), rr = r & 15, cc = c & 31, ob = rr * 64 + cc * 2; return st * 1024 + (ob ^ (((ob >> 9) & 1) << 5)); }
__host__ __device__ __forceinline__ void stage_rc(int b, int& R, int& C) { const int st = b / 1024, sb = b % 1024, swz = sb ^ (((sb >> 9) & 1) << 5); R = (st >> 1) * 16 + swz / 64; C = (st & 1) * 32 + (swz % 64) / 2; }
__host__ __device__ __forceinline__ int perm32(int rho) { const int n = rho >> 4, i = rho & 15; return 8 * (i >> 2) + 4 * n + (i & 3); }

struct Unit { int pm, pn; };
struct Gemm { const bf16_t* A; const bf16_t* Bt; int M, N, K; };

struct StaticOrder {
    int nM, nN, nwg, G, c;
    __host__ __device__ void init(int M, int N, int G_, int c_) { nM = M / BM; nN = N / BM; nwg = nM * nN; G = G_; c = c_; }
    __host__ __device__ bool next(int i, Unit& u) const {
        const long L = (long)i * G + c; if (L >= nwg) return false;
        int wgid = (int)L; { const int q = nwg / NXCD, r = nwg % NXCD, xcd = wgid % NXCD, off = wgid / NXCD; wgid = (xcd < r ? xcd * (q + 1) : r * (q + 1) + (xcd - r) * q) + off; }
        const int nig = WGM * nN, gid = wgid / nig, fm = gid * WGM, gsz = (nM - fm) < WGM ? (nM - fm) : WGM;
        u.pm = fm + ((wgid % nig) % gsz); u.pn = (wgid % nig) / gsz; return true;
    }
    __device__ __forceinline__ void a_ready(const Unit&) const {}
    __device__ __forceinline__ void done(const Unit&) const {}
};

struct SampleOrder {
    int c, G;
    __device__ __forceinline__ bool next(int i, Unit& u) const { if (i != 0 || c < G - 8) return false; u.pm = 32; u.pn = c - (G - 8); return true; }
    __device__ __forceinline__ void a_ready(const Unit&) const {}
    __device__ __forceinline__ void done(const Unit&) const {}
};
typedef __bf16 bf16x2_t __attribute__((ext_vector_type(2)));
typedef float f32x2_t __attribute__((ext_vector_type(2)));
__device__ __forceinline__ unsigned pk2(float lo, float hi) { f32x2_t v = {lo, hi}; bf16x2_t b = __builtin_convertvector(v, bf16x2_t); return __builtin_bit_cast(unsigned, b); }
__device__ __forceinline__ bf16_t f2bf(float f) { return (bf16_t)(pk2(f, 0.f) & 0xffffu); }
__device__ __forceinline__ float bf2f(bf16_t h) { return __uint_as_float(((unsigned)h) << 16); }

struct EpiIn {
    static constexpr bool PERM = true, AFTER_DRAIN = false;
    unsigned char* ws; float* out; int layer;
    __device__ __forceinline__ void operator()(const f32x4 (&acc)[2][2][4][2], const Unit& u, int wr, int wc, int fr_, int fq_) const {
        int lane_ = threadIdx.x & 63; asm volatile("" : "+v"(lane_));
        const int fr = lane_ & 15, fq = lane_ >> 4;
        const int pn = u.pn, pm = u.pm;
        bf16_t* z = (bf16_t*)(ws + WS_Z); const unsigned long long* rowss = (const unsigned long long*)(ws + WS_ROWSS) + layer * MROWS; const float2* rope = (const float2*)(ws + WS_ROPE);
        bf16_t* vT = (bf16_t*)(ws + WS_VT); bf16_t* vaT = (bf16_t*)(ws + WS_VAT);
        const bool is_rope = (pn >= 6 && pn <= 10) && ((wc & 1) == 0);
#pragma unroll
        for (int ai = 0; ai < 2; ++ai)
#pragma unroll
            for (int m = 0; m < 4; ++m) {
                const int r = pm * BM + ai * HALF + wr * 64 + m * 16 + fr;
                const float rs = rsqrtf((float)rowss[r] * (2.3283064365386963e-10f / 2048.0f) + 1e-5f);
                const int pi = (r < 8192) ? (r & 4095) : (4096 + ((r - 8192) & 7));
#pragma unroll
                for (int bj = 0; bj < 2; ++bj) {
                    f32x4 v0 = acc[ai][bj][m][0] * rs, v1 = acc[ai][bj][m][1] * rs;
                    const int c = pn * BM + bj * HALF + wc * 32 + 8 * fq;
                    if (is_rope) {
                        f32x4 p0, p1;
#pragma unroll
                        for (int e = 0; e < 4; ++e) { p0[e] = __shfl_xor(v0[e], 16); p1[e] = __shfl_xor(v1[e], 16); }
                        if (fq < 2) {
                            const float2* cs = rope + (size_t)pi * 8;
                            const float sg = (fq == 0) ? -1.0f : 1.0f;
#pragma unroll
                            for (int e = 0; e < 4; ++e) {
                                const float2 c0 = cs[e], c1 = cs[4 + e];
                                v0[e] = v0[e] * c0.x + sg * p0[e] * c0.y;
                                v1[e] = v1[e] * c1.x + sg * p1[e] * c1.y;
                            }
                        }
                    }
                    u32x4 w; w.x = pk2(v0[0], v0[1]); w.y = pk2(v0[2], v0[3]); w.z = pk2(v1[0], v1[1]); w.w = pk2(v1[2], v1[3]);
                    *(u32x4*)(z + (size_t)r * DIN + c) = w;
                    if (pn == 10 || pn == 11) {
                        const int cc = c - pn * BM;
                        float* o = nullptr;
                        if (pm == 32) o = out + (pn == 10 ? OFF_KS : OFF_VS) + ((size_t)(layer * 256 + (r - 8192))) * 256 + cc;
                        else if ((pm & 15) == 15 && ai == 1) o = out + (pn == 10 ? OFF_KP : OFF_VP) + ((size_t)((layer * 2 + (pm >> 4)) * 128 + ((r & 4095) - 3968))) * 256 + cc;
                        if (o) { *(f32x4*)o = v0; *(f32x4*)(o + 4) = v1; }
                        if (pn == 11 && pm < 32) {
                            const int b = r >> 12, t = r & 4095;
                            bf16_t* vp = vT + ((size_t)(b * 256 + cc)) * 4096 + t;
#pragma unroll
                            for (int e = 0; e < 8; ++e) vp[(size_t)e * 4096] = (bf16_t)((w[e >> 1] >> (16 * (e & 1))) & 0xffffu);
                        }
                    }
                    if (pn == 2 || pn == 3) {
                        const int ch = c - C_VA;
                        if (pm < 32) {
                            bf16_t* vp = vaT + (size_t)ch * 8192 + r;
#pragma unroll
                            for (int e = 0; e < 8; ++e) vp[(size_t)e * 8192] = (bf16_t)((w[e >> 1] >> (16 * (e & 1))) & 0xffffu);
                        } else {
                            float* o = out + OFF_VA + ((size_t)(layer * 256 + (r - 8192))) * 512 + ch;
                            *(f32x4*)o = v0; *(f32x4*)(o + 4) = v1;
                        }
                    }
                }
            }
    }
};

struct EpiOut {
    static constexpr bool PERM = false, AFTER_DRAIN = false;
    const float* xp; const float* xs; unsigned char* ws; int layer;
    __device__ __forceinline__ void operator()(const f32x4 (&acc)[2][2][4][2], const Unit& u, int wr, int wc, int fr_, int fq_) const {
        int lane_ = threadIdx.x & 63; asm volatile("" : "+v"(lane_));
        const int fr = lane_ & 15, fq = lane_ >> 4;
        float* xres = (float*)(ws + WS_XRES); bf16_t* xb = (bf16_t*)(ws + WS_XB); unsigned long long* rowss_next = (unsigned long long*)(ws + WS_ROWSS) + (layer + 1) * MROWS;
#pragma unroll
        for (int ai = 0; ai < 2; ++ai)
#pragma unroll
            for (int m = 0; m < 4; ++m) {
                const int r = u.pm * BM + ai * HALF + wr * 64 + m * 16 + fr;
                const float* xo = (r < 8192) ? (xp + (size_t)r * DM) : (xs + (size_t)(r - 8192) * DM);
                float ss = 0.f;
#pragma unroll
                for (int bj = 0; bj < 2; ++bj)
#pragma unroll
                    for (int n = 0; n < 2; ++n) {
                        const int c = u.pn * BM + bj * HALF + wc * 32 + 16 * n + 4 * fq;
                        const f32x4 o = *(const f32x4*)(xo + c) + acc[ai][bj][m][n];
                        *(f32x4*)(xres + (size_t)r * DM + c) = o;
                        u32x2 w; w.x = pk2(o[0], o[1]); w.y = pk2(o[2], o[3]);
                        *(u32x2*)(xb + (size_t)r * DM + c) = w;
                        ss += (o[0] * o[0] + o[1] * o[1]) + (o[2] * o[2] + o[3] * o[3]);
                    }
                ss += __shfl_xor(ss, 16); ss += __shfl_xor(ss, 32);
                if (fq == 0) atomicAdd(rowss_next + r, (unsigned long long)(ss * 4294967296.0f));
                asm volatile("" ::: "memory");
            }
    }
};

template <class Epi, class Sched, bool ALIGN_EPI = false, bool SP2 = false>
__device__ __forceinline__ void gemm_phase(PG8_LAS unsigned char* lds, const Gemm g, const Sched& S, const Epi& E) {
    int tid_ = threadIdx.x; asm volatile("" : "+v"(tid_));
    const int tid = tid_, wid = __builtin_amdgcn_readfirstlane(tid >> 6), lane = tid & 63, wr = wid >> 2, wc = wid & 3, fr = lane & 15, fq = lane >> 4;
    const int K = g.K, nt = K / BK;
    unsigned voffA[2], voffB[2];
#pragma unroll
    for (int i = 0; i < 2; ++i) { int R, C; stage_rc(tid * 16 + i * 8192, R, C); const int Rb = Epi::PERM ? ((R & ~31) + perm32(R & 31)) : R;
        voffA[i] = (unsigned)(R * K + C) * 2u; voffB[i] = (unsigned)(Rb * K + C) * 2u; }
    const size_t kstep = (size_t)(BK * 2);
    const size_t hstep = (size_t)HALF * K * 2;
    const size_t tstep = 2 * hstep;
    const unsigned ldsw = (unsigned)wid * 1024u;
    const int aoff = lds_byte(wr * 64 + fr, fq * 8), boff = lds_byte(wc * 32 + fr, fq * 8);
#define PG8_SA(b, h) (((b) * 2 + (h)) * HTB)
#define PG8_SB(b, h) ((4 + (b) * 2 + (h)) * HTB)
#define PG8_STAGE(bufoff, gbase, voff) do { _Pragma("unroll") for (int _i = 0; _i < 2; ++_i) \
        __builtin_amdgcn_global_load_lds((const unsigned*)((const char*)(gbase) + (voff)[_i]), (PG8_LAS unsigned*)(lds + (bufoff) + ldsw + _i * 8192), 16, 0, 0); } while (0)
#define PG8_LDA(dst, b, h) do { _Pragma("unroll") for (int m = 0; m < 4; ++m) _Pragma("unroll") for (int k = 0; k < 2; ++k) dst[m][k] = *(const PG8_LAS bf16x8*)(lds + PG8_SA(b, h) + aoff + m * 2048 + k * 1024); } while (0)
#define PG8_LDB(dst, b, h) do { _Pragma("unroll") for (int n = 0; n < 2; ++n) _Pragma("unroll") for (int k = 0; k < 2; ++k) dst[n][k] = *(const PG8_LAS bf16x8*)(lds + PG8_SB(b, h) + boff + n * 2048 + k * 1024); } while (0)
#define PG8_MMA(ai, bj, At, Bt) do { __builtin_amdgcn_s_setprio(1); _Pragma("unroll") for (int m = 0; m < 4; ++m) _Pragma("unroll") for (int n = 0; n < 2; ++n) _Pragma("unroll") for (int k = 0; k < 2; ++k) \
        acc[ai][bj][m][n] = __builtin_amdgcn_mfma_f32_16x16x32_bf16(Bt[n][k], At[m][k], acc[ai][bj][m][n], 0, 0, 0); __builtin_amdgcn_s_setprio(0); } while (0)
#define PG8_WAIT_V(n) asm volatile("s_waitcnt vmcnt(" #n ")" ::: "memory")
#define PG8_WAIT_L(n) asm volatile("s_waitcnt lgkmcnt(" #n ")" ::: "memory")
#define PG8_BAR __builtin_amdgcn_s_barrier()
#define PG8_SCHED __builtin_amdgcn_sched_barrier(0)
    Unit cur, nxt; int ui = 0;
    if (!S.next(0, cur)) return;
    f32x4 acc[2][2][4][2];
#pragma unroll
    for (int a = 0; a < 2; ++a)
#pragma unroll
        for (int b = 0; b < 2; ++b)
#pragma unroll
            for (int m = 0; m < 4; ++m)
#pragma unroll
                for (int n = 0; n < 2; ++n) acc[a][b][m][n] = (f32x4){0.f, 0.f, 0.f, 0.f};
    bf16x8 At[4][2], B0[2][2], B1[2][2];
    const char* cA = (const char*)g.A + (size_t)cur.pm * tstep; const char* cB = (const char*)g.Bt + (size_t)cur.pn * tstep;
    S.a_ready(cur);
    if constexpr (SP2) {
        PG8_STAGE(PG8_SB(0, 0), cB, voffB); PG8_STAGE(PG8_SB(0, 1), cB + hstep, voffB); PG8_STAGE(PG8_SA(0, 0), cA, voffA); PG8_STAGE(PG8_SA(0, 1), cA + hstep, voffA);
        if (wr == 1) PG8_BAR;
        PG8_WAIT_V(2); PG8_BAR;
        PG8_STAGE(PG8_SB(1, 0), cB + kstep, voffB); PG8_STAGE(PG8_SA(1, 0), cA + kstep, voffA); PG8_STAGE(PG8_SB(1, 1), cB + hstep + kstep, voffB);
        PG8_WAIT_V(6); PG8_BAR;
    } else {
        PG8_STAGE(PG8_SB(0, 0), cB, voffB); PG8_STAGE(PG8_SA(0, 0), cA, voffA); PG8_STAGE(PG8_SB(0, 1), cB + hstep, voffB); PG8_STAGE(PG8_SA(0, 1), cA + hstep, voffA);
        if (wr == 1) PG8_BAR;
        PG8_WAIT_V(4); PG8_BAR;
        PG8_STAGE(PG8_SB(1, 0), cB + kstep, voffB); PG8_STAGE(PG8_SA(1, 0), cA + kstep, voffA); PG8_STAGE(PG8_SB(1, 1), cB + hstep + kstep, voffB);
        PG8_WAIT_V(6); PG8_BAR;
    }
    for (;;) {
        const bool has_next = S.next(ui + 1, nxt);
        const char* nA = has_next ? (const char*)g.A + (size_t)nxt.pm * tstep : cA; const char* nB = has_next ? (const char*)g.Bt + (size_t)nxt.pn * tstep : cB;
        for (int t = 0; t < nt; t += 2) {
            const bool last = (t == nt - 2);
            const char* a1 = cA + (size_t)(t + 1) * kstep;
            const char* a2 = last ? nA : cA + (size_t)(t + 2) * kstep; const char* b2 = last ? nB : cB + (size_t)(t + 2) * kstep;
            const char* a3 = a2 + kstep; const char* b3 = b2 + kstep;
            if (last && has_next) S.a_ready(nxt);
            if constexpr (SP2) {
            PG8_LDB(B0, 0, 0); PG8_LDB(B1, 0, 1); PG8_SCHED; PG8_LDA(At, 0, 0); PG8_STAGE(PG8_SA(1, 1), a1 + hstep, voffA);
            PG8_WAIT_V(8); PG8_WAIT_L(0); PG8_BAR; PG8_MMA(0, 0, At, B0); PG8_MMA(0, 1, At, B1); PG8_BAR; PG8_SCHED;
            PG8_LDA(At, 0, 1); PG8_STAGE(PG8_SB(0, 0), b2, voffB); PG8_STAGE(PG8_SB(0, 1), b2 + hstep, voffB); PG8_STAGE(PG8_SA(0, 0), a2, voffA);
            PG8_WAIT_V(8); PG8_WAIT_L(0); PG8_BAR; PG8_MMA(1, 0, At, B0); PG8_MMA(1, 1, At, B1); PG8_BAR; PG8_SCHED;
            PG8_LDB(B0, 1, 0); PG8_LDB(B1, 1, 1); PG8_SCHED; PG8_LDA(At, 1, 0); PG8_STAGE(PG8_SA(0, 1), a2 + hstep, voffA);
            PG8_WAIT_V(8); PG8_WAIT_L(0); PG8_BAR; PG8_MMA(0, 0, At, B0); PG8_MMA(0, 1, At, B1); PG8_BAR; PG8_SCHED;
            PG8_LDA(At, 1, 1); PG8_STAGE(PG8_SB(1, 0), b3, voffB); PG8_STAGE(PG8_SB(1, 1), b3 + hstep, voffB); PG8_STAGE(PG8_SA(1, 0), a3, voffA);
            PG8_WAIT_V(8); PG8_WAIT_L(0); PG8_BAR; PG8_MMA(1, 0, At, B0); PG8_MMA(1, 1, At, B1); PG8_BAR; PG8_SCHED;
            } else {
            PG8_LDB(B0, 0, 0); PG8_SCHED; PG8_LDA(At, 0, 0); PG8_STAGE(PG8_SA(1, 1), a1 + hstep, voffA);
            PG8_WAIT_L(8); PG8_BAR; PG8_WAIT_L(0); PG8_MMA(0, 0, At, B0); PG8_BAR; PG8_SCHED;
            PG8_LDB(B1, 0, 1); PG8_STAGE(PG8_SB(0, 0), b2, voffB);
            PG8_BAR; PG8_WAIT_L(0); PG8_MMA(0, 1, At, B1); PG8_BAR;
            PG8_LDA(At, 0, 1); PG8_STAGE(PG8_SA(0, 0), a2, voffA);
            PG8_BAR; PG8_WAIT_L(0); PG8_MMA(1, 0, At, B0); PG8_BAR; PG8_SCHED;
            PG8_STAGE(PG8_SB(0, 1), b2 + hstep, voffB);
            PG8_WAIT_V(6); PG8_BAR; PG8_MMA(1, 1, At, B1); PG8_BAR;
            PG8_LDB(B0, 1, 0); PG8_SCHED; PG8_LDA(At, 1, 0); PG8_STAGE(PG8_SA(0, 1), a2 + hstep, voffA);
            PG8_WAIT_L(8); PG8_BAR; PG8_WAIT_L(0); PG8_MMA(0, 0, At, B0); PG8_BAR; PG8_SCHED;
            PG8_LDB(B1, 1, 1); PG8_STAGE(PG8_SB(1, 0), b3, voffB);
            PG8_BAR; PG8_WAIT_L(0); PG8_MMA(0, 1, At, B1); PG8_BAR;
            PG8_LDA(At, 1, 1); PG8_STAGE(PG8_SA(1, 0), a3, voffA);
            PG8_BAR; PG8_WAIT_L(0); PG8_MMA(1, 0, At, B0); PG8_BAR; PG8_SCHED;
            PG8_STAGE(PG8_SB(1, 1), b3 + hstep, voffB);
            PG8_WAIT_V(6); PG8_BAR; PG8_MMA(1, 1, At, B1); PG8_BAR;
            }
        }
        if constexpr (ALIGN_EPI) { if (wr == 0) PG8_BAR; }
        if constexpr (!Epi::AFTER_DRAIN) { E(acc, cur, wr, wc, fr, fq); S.done(cur); }
        if (!has_next) break;
#pragma unroll
        for (int a = 0; a < 2; ++a)
#pragma unroll
            for (int b = 0; b < 2; ++b)
#pragma unroll
                for (int m = 0; m < 4; ++m)
#pragma unroll
                    for (int n = 0; n < 2; ++n) acc[a][b][m][n] = (f32x4){0.f, 0.f, 0.f, 0.f};
        cur = nxt; cA = nA; cB = nB; ++ui;
        if constexpr (ALIGN_EPI) { if (wr == 1) PG8_BAR; }
    }
    PG8_WAIT_V(0);
    if constexpr (!ALIGN_EPI) { if (wr == 0) PG8_BAR; }
    PG8_BAR;
    if constexpr (Epi::AFTER_DRAIN) { E.fused(acc, cur, wr, wc, fr, fq, lds, wid, lane); S.done(cur); }
#undef PG8_SA
#undef PG8_SB
#undef PG8_STAGE
#undef PG8_LDA
#undef PG8_LDB
#undef PG8_MMA
#undef PG8_WAIT_V
#undef PG8_WAIT_L
#undef PG8_BAR
#undef PG8_SCHED
}
}

using pg8::bf16_t; using pg8::bf16x8; using pg8::f32x4; using pg8::u32x4; using pg8::u32x2; using pg8::pk2; using pg8::f2bf; using pg8::bf2f;
#define LAS __attribute__((address_space(3)))
typedef short s16x4 __attribute__((ext_vector_type(4)));
typedef float f32x16 __attribute__((ext_vector_type(16)));
#define MFMA32(a, b, c) __builtin_amdgcn_mfma_f32_32x32x16_bf16((a), (b), (c), 0, 0, 0)
#define MFMA16(a, b, c) __builtin_amdgcn_mfma_f32_16x16x32_bf16((a), (b), (c), 0, 0, 0)
#define LDS_FENCE() asm volatile("s_waitcnt lgkmcnt(0)" ::: "memory")
#define DI __device__ __forceinline__
constexpr int NWAVES = 8, NTHREADS = 512;
constexpr int LDS_BYTES = 147456;
constexpr int WSCR = 8448;
constexpr int YG_OFF = NWAVES * WSCR;
constexpr int YG_LD = 520;

DI int crow(int reg, int h) { return (reg & 3) + 8 * (reg >> 2) + 4 * h; }
DI float sigmoidf_(float x) { return 1.0f / (1.0f + __expf(-x)); }
DI float siluf_(float x) { return x * sigmoidf_(x); }
DI float gelu_tanh(float y) { const float t = 0.7978845608028654f * (y + 0.044715f * y * y * y); const float th = 1.0f - 2.0f / (__expf(2.0f * t) + 1.0f); return 0.5f * y * (1.0f + th); }
DI float wave_sum(float v) {
#pragma unroll
    for (int o = 1; o < 64; o <<= 1) v += __shfl_xor(v, o);
    return v;
}
DI float wave_max(float v) {
#pragma unroll
    for (int o = 1; o < 64; o <<= 1) v = fmaxf(v, __shfl_xor(v, o));
    return v;
}
DI void sincos_d(double ang, float& s, float& c) {
    const double TWO_PI = 6.283185307179586476925, INV_TWO_PI = 0.15915494309189533576888;
    const double k = rint(ang * INV_TWO_PI);
    const double r = ang - k * TWO_PI, r2 = r * r;
    double ss = 1.0, cc = 1.0;
#pragma unroll
    for (int n = 15; n >= 1; --n) { ss = 1.0 - ss * r2 * (1.0 / ((2.0 * n) * (2.0 * n + 1.0))); cc = 1.0 - cc * r2 * (1.0 / ((2.0 * n - 1.0) * (2.0 * n))); }
    s = (float)(r * ss); c = (float)cc;
}

constexpr int PTR_OFF = 140 * 1024, XB_LDS_OFF = 140 * 1024 + 512;
constexpr size_t WS_XBAR = 512 * 1024;
struct Ctx { unsigned char* ws; float* out; LAS unsigned char* lds; int lane, wave, gw, ngw; };
#define GAS __attribute__((address_space(1)))
DI const GAS float* INP(const Ctx& X, int i) { const volatile LAS unsigned* p = (const volatile LAS unsigned*)(X.lds + PTR_OFF + 8 * i);
    const unsigned lo = __builtin_amdgcn_readfirstlane(p[0]), hi = __builtin_amdgcn_readfirstlane(p[1]); return (const GAS float*)(((unsigned long long)hi << 32) | lo); }
#define W_ROWSS(X) ((unsigned long long*)((X).ws + WS_ROWSS))
#define W_AB(X)    ((float2*)((X).ws + WS_AB))
#define W_AT(X)    ((float2*)((X).ws + WS_AT))
#define W_BB(X)    ((bf16_t*)((X).ws + WS_BB))
#define W_CC(X)    ((bf16_t*)((X).ws + WS_CC))
#define W_ROPE(X)  ((float2*)((X).ws + WS_ROPE))
#define W_WSB(X)   ((bf16_t*)((X).ws + WS_WSB))
#define W_WGT(X)   ((bf16_t*)((X).ws + WS_WGT))
#define W_WOT(X)   ((bf16_t*)((X).ws + WS_WOT))
#define W_WIT(X)   ((bf16_t*)((X).ws + WS_WIT))
#define W_XB(X)    ((bf16_t*)((X).ws + WS_XB))
#define W_XRES(X)  ((float*)((X).ws + WS_XRES))
#define W_Z(X)     ((bf16_t*)((X).ws + WS_Z))
#define W_MIX(X)   ((bf16_t*)((X).ws + WS_MIX))
#define W_VT(X)    ((bf16_t*)((X).ws + WS_VT))
#define W_VAT(X)   ((bf16_t*)((X).ws + WS_VAT))
#define W_E(X)     ((float2*)((X).ws + WS_E))
#define W_H0(X)    ((float2*)((X).ws + WS_H0))
enum { I_XP = 0, I_XS, I_CK, I_CV, I_SRE, I_SIM, I_NG, I_FG, I_WIN, I_WOUT, I_CW, I_CB, I_SINK, I_ARE, I_AIM, I_LDT, I_BRE, I_BIM, I_CRE, I_CIM, I_DSK, I_GW, I_GB };

DI void p0_transpose_item(const GAS float* W, const GAS float* gk, int K, int N, bf16_t* WT, LAS float* scr, int item, int lane) {
    const int nblk = N / 32, kb = item / nblk, nb = item % nblk, k0 = 64 * kb, n0 = 32 * nb;
    const int r8 = lane >> 3, c4 = (lane & 7) * 4;
#pragma unroll
    for (int i = 0; i < 8; ++i) { const int kk = 8 * i + r8; f32x4 v = *(const GAS f32x4*)(W + (size_t)(k0 + kk) * N + n0 + c4); if (gk) v = v * gk[k0 + kk];
        LAS float* d = scr + kk * 33 + c4; d[0] = v[0]; d[1] = v[1]; d[2] = v[2]; d[3] = v[3]; }
    LDS_FENCE();
    const int c = lane & 7;
#pragma unroll
    for (int j = 0; j < 4; ++j) { const int n = (lane >> 3) + 8 * j; const LAS float* s = scr + (8 * c) * 33 + n;
        u32x4 o; o.x = pk2(s[0 * 33], s[1 * 33]); o.y = pk2(s[2 * 33], s[3 * 33]); o.z = pk2(s[4 * 33], s[5 * 33]); o.w = pk2(s[6 * 33], s[7 * 33]);
        *(u32x4*)(WT + (size_t)(n0 + n) * K + k0 + 8 * c) = o; }
    LDS_FENCE();
}

DI void convert_layer_weights(const Ctx& X, int l, int w_id, int n_w) {
    LAS float* scr = (LAS float*)(X.lds + X.wave * WSCR);
    constexpr int I_IN = (DM / 64) * (DIN / 32), I_OUT = (DM / 64) * (DM / 32), I_G = (512 / 64) * (512 / 32), I_L = I_IN + I_OUT + I_G;
    const GAS float* w_in = INP(X, I_WIN); const GAS float* w_out = INP(X, I_WOUT); const GAS float* glu_w = INP(X, I_GW); const GAS float* norm_g = INP(X, I_NG);
    for (int it = w_id; it < I_L; it += n_w) {
        int r = it;
        if (r < I_IN) { p0_transpose_item(w_in + (size_t)l * DM * DIN, norm_g + l * DM, DM, DIN, W_WIT(X) + (size_t)l * DIN * DM, scr, r, X.lane); continue; } r -= I_IN;
        if (r < I_OUT) { p0_transpose_item(w_out + (size_t)l * DM * DM, nullptr, DM, DM, W_WOT(X) + (size_t)l * DM * DM, scr, r, X.lane); continue; } r -= I_OUT;
        p0_transpose_item(glu_w + (size_t)l * 512 * 512, nullptr, 512, 512, W_WGT(X) + (size_t)l * 512 * 512, scr, r, X.lane);
    }
}

DI void phase_prologue(const Ctx& X) {
    convert_layer_weights(X, 0, X.gw, X.ngw);
    if (gridDim.x < 16) { for (int l = 1; l < NLAYER; ++l) convert_layer_weights(X, l, X.gw, X.ngw); }
    { const GAS float* x_prompt = INP(X, I_XP); const GAS float* x_sample = INP(X, I_XS);
    for (int m = X.gw; m < MROWS; m += X.ngw) {
        const GAS float* xr = (m < 8192) ? (x_prompt + (size_t)m * DM) : (x_sample + (size_t)(m - 8192) * DM);
        float ss = 0.f;
#pragma unroll
        for (int j = 0; j < 8; ++j) { const f32x4 v = *(const GAS f32x4*)(xr + 4 * X.lane + 256 * j); ss += (v[0] * v[0] + v[1] * v[1]) + (v[2] * v[2] + v[3] * v[3]);
            u32x2 w; w.x = pk2(v[0], v[1]); w.y = pk2(v[2], v[3]); *(u32x2*)(W_XB(X) + (size_t)m * DM + 4 * X.lane + 256 * j) = w; }
        ss = wave_sum(ss);
        if (X.lane == 0) W_ROWSS(X)[m] = (unsigned long long)(ss * 4294967296.0f);
    } }
    const int gt = X.gw * 64 + X.lane, ngt = X.ngw * 64;
    { const GAS float* log_dt = INP(X, I_LDT); const GAS float* a_re = INP(X, I_ARE); const GAS float* a_im = INP(X, I_AIM); const GAS float* b_re = INP(X, I_BRE); const GAS float* b_im = INP(X, I_BIM);
      const GAS float* c_re = INP(X, I_CRE); const GAS float* c_im = INP(X, I_CIM);
    for (int i = gt; i < NLAYER * 32 * 64; i += ngt) {
        const int lg = i >> 6, p = i & 63;
        const float dt = expf(log_dt[lg]); const float ar = a_re[i], ai = a_im[i];
        float sn, cs; sincos_d((double)ai * (double)dt, sn, cs);
        const float mag = expf(ar * dt); const float abr = mag * cs, abi = mag * sn;
        W_AB(X)[i] = make_float2(abr, abi);
        float sn32, cs32; sincos_d((double)ai * (double)dt * 32.0, sn32, cs32);
        const float mag32 = expf(ar * dt * 32.0f);
        W_AT(X)[i] = make_float2(mag32 * cs32, mag32 * sn32);
        const float nr = abr - 1.0f, ni = abi, den = ar * ar + ai * ai;
        const float f_re = (nr * ar + ni * ai) / den, f_im = (ni * ar - nr * ai) / den;
        unsigned wr[8], wi[8];
#pragma unroll
        for (int c2 = 0; c2 < 8; ++c2) {
            const float br0 = b_re[(size_t)i * 16 + 2 * c2], bi0 = b_im[(size_t)i * 16 + 2 * c2], br1 = b_re[(size_t)i * 16 + 2 * c2 + 1], bi1 = b_im[(size_t)i * 16 + 2 * c2 + 1];
            wr[c2] = pk2(f_re * br0 - f_im * bi0, f_re * br1 - f_im * bi1);
            wi[c2] = pk2(f_re * bi0 + f_im * br0, f_re * bi1 + f_im * br1);
        }
        u32x4* rowr = (u32x4*)(W_BB(X) + ((size_t)lg * 128 + p) * 16); u32x4* rowi = (u32x4*)(W_BB(X) + ((size_t)lg * 128 + 64 + p) * 16);
        rowr[0] = (u32x4){wr[0], wr[1], wr[2], wr[3]}; rowr[1] = (u32x4){wr[4], wr[5], wr[6], wr[7]};
        rowi[0] = (u32x4){wi[0], wi[1], wi[2], wi[3]}; rowi[1] = (u32x4){wi[4], wi[5], wi[6], wi[7]};
    }
    for (int j = gt; j < NLAYER * 32 * 16 * 16; j += ngt) {
        const int kc = j & 15, lc = j >> 4, k0 = 8 * kc;
        const GAS float* src = (k0 < 64) ? (c_re + (size_t)lc * 64 + k0) : (c_im + (size_t)lc * 64 + (k0 - 64));
        const float sg = (k0 < 64) ? 1.0f : -1.0f;
        const f32x4 a0 = *(const GAS f32x4*)src, a1 = *(const GAS f32x4*)(src + 4);
        u32x4 w; w.x = pk2(sg * a0[0], sg * a0[1]); w.y = pk2(sg * a0[2], sg * a0[3]); w.z = pk2(sg * a1[0], sg * a1[1]); w.w = pk2(sg * a1[2], sg * a1[3]);
        *(u32x4*)(W_CC(X) + (size_t)lc * 128 + k0) = w;
    } }
    { const GAS float* chunk_w = INP(X, I_CW);
    for (int j = gt; j < NLAYER * 4 * 128 * 16; j += ngt) {
        const int t = (j >> 4) & 127, s0 = (j & 15) * 8;
        const f32x4 a0 = *(const GAS f32x4*)(chunk_w + (size_t)j * 8), a1 = *(const GAS f32x4*)(chunk_w + (size_t)j * 8 + 4);
        float v[8] = {a0[0], a0[1], a0[2], a0[3], a1[0], a1[1], a1[2], a1[3]};
#pragma unroll
        for (int e = 0; e < 8; ++e) v[e] = (s0 + e <= t) ? v[e] : 0.0f;
        u32x4 w; w.x = pk2(v[0], v[1]); w.y = pk2(v[2], v[3]); w.z = pk2(v[4], v[5]); w.w = pk2(v[6], v[7]);
        *(u32x4*)(W_WSB(X) + (size_t)j * 8) = w;
    } }
    for (int i = gt; i < 4104 * 8; i += ngt) {
        const int pi = i >> 3, j = i & 7;
        const double inv[8] = {1.0, 0.19392274474868576, 0.03760603093086393, 0.007292664737217109, 0.001414213562373095, 0.0002742481756762073, 5.318295896944988e-05, 1.031338537721246e-05};
        double iv = inv[0];
#pragma unroll
        for (int q = 1; q < 8; ++q) iv = (j == q) ? inv[q] : iv;
        const double pos = (pi < 4096) ? (double)pi : (double)(16384 + (pi - 4096));
        float sn, cs; sincos_d(pos * iv, sn, cs);
        W_ROPE(X)[i] = make_float2(cs, sn);
    }
}

DI float2 ld_e(const float2* p) { const unsigned long long v = __hip_atomic_load((const unsigned long long*)p, __ATOMIC_RELAXED, __HIP_MEMORY_SCOPE_SYSTEM); float2 r; r.x = __uint_as_float((unsigned)v); r.y = __uint_as_float((unsigned)(v >> 32)); return r; }
template <bool PASS_C>
DI void s5_wave_unit(const Ctx& X, int layer, int u, int slot, LAS float* bu, LAS bf16_t* yg) {
    const int lane = X.lane, r31 = lane & 31, h = lane >> 5;
    const int R0 = 32 * u; const bool samp = (u >= 256);
    const int b = u >> 7, chn = u & 127;
    const GAS float* st_re = INP(X, I_SRE); const GAS float* st_im = INP(X, I_SIM); const GAS float* dskip = INP(X, I_DSK);
    for (int gi = 0; gi < 4; ++gi) {
        const int g = 4 * slot + gi, lg = layer * 32 + g;
        const float2 ab = W_AB(X)[lg * 64 + lane];
        float hr = 0.f, hi = 0.f;
        if (PASS_C && !samp) { const float2 h0 = W_H0(X)[((size_t)(b * 128 + chn) * 32 + g) * 64 + lane]; hr = h0.x; hi = h0.y; }
        bf16x8 ua = *(const bf16x8*)(W_Z(X) + (size_t)(R0 + r31) * DIN + C_UC + 16 * g + 8 * h);
        bf16x8 bbf[4];
#pragma unroll
        for (int nt = 0; nt < 4; ++nt) bbf[nt] = *(const bf16x8*)(W_BB(X) + ((size_t)lg * 128 + 32 * nt + r31) * 16 + 8 * h);
        f32x16 acc[4];
#pragma unroll
        for (int nt = 0; nt < 4; ++nt) {
            f32x16 zz;
#pragma unroll
            for (int i = 0; i < 16; ++i) zz[i] = 0.f;
            asm volatile("" : "+v"(zz));
            acc[nt] = MFMA32(ua, bbf[nt], zz);
        }
        __builtin_amdgcn_sched_barrier(0);
        asm volatile("s_nop 15\n\ts_nop 15\n\ts_nop 15\n\ts_nop 15\n\ts_nop 15\n\ts_nop 15\n\ts_nop 15\n\ts_nop 15"
                     : "+v"(ua), "+v"(bbf[0]), "+v"(bbf[1]), "+v"(bbf[2]), "+v"(bbf[3]), "+v"(acc[0]), "+v"(acc[1]), "+v"(acc[2]), "+v"(acc[3]) :: "memory");
        __builtin_amdgcn_sched_barrier(0);
        bf16x8 cfrag[4];
        if (PASS_C) {
#pragma unroll
            for (int kk = 0; kk < 4; ++kk) cfrag[kk] = *(const bf16x8*)(W_CC(X) + ((size_t)lg * 16 + (lane & 15)) * 128 + 32 * kk + 8 * (lane >> 4));
        }
        const float dsk = PASS_C ? dskip[layer * 512 + 16 * g + (lane & 15)] : 0.f;
#pragma unroll
        for (int half = 0; half < 2; ++half) {
#pragma unroll
            for (int nt = 0; nt < 4; ++nt)
#pragma unroll
                for (int rr = 0; rr < 8; ++rr) bu[((rr & 3) + 8 * (rr >> 2) + 4 * h) * 132 + 32 * nt + r31] = acc[nt][8 * half + rr];
            LDS_FENCE();
            for (int tl = 0; tl < 16; ++tl) {
                const int t = 16 * half + tl;
                if (samp && (t & 7) == 0) { const size_t si = ((size_t)(layer * 32 + ((R0 - 8192 + t) >> 3)) * 32 + g) * 64 + lane; hr = st_re[si]; hi = st_im[si]; }
                const float br = bu[tl * 132 + lane], bi = bu[tl * 132 + 64 + lane];
                const float nr = ab.x * hr - ab.y * hi + br, ni = ab.x * hi + ab.y * hr + bi; hr = nr; hi = ni;
                if (PASS_C) {
                    LDS_FENCE();
                    LAS bf16_t* hs = (LAS bf16_t*)(bu + tl * 132); hs[lane] = f2bf(hr); hs[64 + lane] = f2bf(hi);
                    if (samp && (t & 7) == 7) { const size_t so = ((size_t)(layer * 32 + ((R0 - 8192 + t) >> 3)) * 32 + g) * 64 + lane; X.out[OFF_HRS + so] = hr; X.out[OFF_HIS + so] = hi; }
                }
            }
            LDS_FENCE();
            if (PASS_C) {
                f32x4 d = {0.f, 0.f, 0.f, 0.f}; asm volatile("" : "+v"(d));
#pragma unroll
                for (int kk = 0; kk < 4; ++kk) { const bf16x8 a = *(const LAS bf16x8*)((const LAS unsigned char*)bu + (lane & 15) * 528 + (32 * kk + 8 * (lane >> 4)) * 2); d = MFMA16(a, cfrag[kk], d); }
                __builtin_amdgcn_sched_barrier(0); asm volatile("s_nop 15\n\ts_nop 15\n\ts_nop 15" ::: "memory"); __builtin_amdgcn_sched_barrier(0);
                const int ch = 16 * g + (lane & 15);
#pragma unroll
                for (int reg = 0; reg < 4; ++reg) { const int t = 16 * half + 4 * (lane >> 4) + reg; const float uval = bf2f(W_Z(X)[(size_t)(R0 + t) * DIN + C_UC + ch]);
                    yg[t * YG_LD + ch] = f2bf(gelu_tanh(d[reg] + dsk * uval)); }
                LDS_FENCE();
            }
        }
        if (!PASS_C) { W_E(X)[((size_t)(b * 128 + chn) * 32 + g) * 64 + lane] = make_float2(hr, hi); }
        else if (!samp && chn == 127) { const size_t so = ((size_t)(layer * 2 + b) * 32 + g) * 64 + lane; X.out[OFF_HRP + so] = hr; X.out[OFF_HIP + so] = hi; }
    }
}

DI void phase_s5c(const Ctx& X, int layer, int u_first, int u_end) {
    LAS float* bu = (LAS float*)(X.lds + X.wave * WSCR);
    LAS bf16_t* yg = (LAS bf16_t*)(X.lds + YG_OFF);
    const int lane = X.lane, r31 = lane & 31, h = lane >> 5;
    const GAS float* glu_b = INP(X, I_GB);
    for (int u = u_first; u < u_end; u += gridDim.x) {
        s5_wave_unit<true>(X, layer, u, X.wave, bu, yg);
        LDS_FENCE(); __syncthreads();
        f32x16 ga[2];
#pragma unroll
        for (int nt = 0; nt < 2; ++nt)
#pragma unroll
            for (int i = 0; i < 16; ++i) ga[nt][i] = 0.f;
        asm volatile("" : "+v"(ga[0]), "+v"(ga[1]));
        const bf16_t* wg = W_WGT(X) + ((size_t)layer * 512 + 64 * X.wave + r31) * 512 + 8 * h;
#pragma unroll 1
        for (int kb = 0; kb < 4; ++kb) {
            bf16x8 af8[8], bf8[8][2];
#pragma unroll
            for (int k8 = 0; k8 < 8; ++k8) { const int ks = 8 * kb + k8; af8[k8] = *(const LAS bf16x8*)(yg + r31 * YG_LD + 16 * ks + 8 * h);
#pragma unroll
                for (int nt = 0; nt < 2; ++nt) bf8[k8][nt] = *(const bf16x8*)(wg + (size_t)nt * 32 * 512 + 16 * ks); }
#pragma unroll
            for (int k8 = 0; k8 < 8; ++k8)
#pragma unroll
                for (int nt = 0; nt < 2; ++nt) ga[nt] = MFMA32(af8[k8], bf8[k8][nt], ga[nt]);
            __builtin_amdgcn_sched_barrier(0); asm volatile("s_nop 15\n\ts_nop 15\n\ts_nop 15\n\ts_nop 15\n\ts_nop 15\n\ts_nop 15" ::: "memory"); __builtin_amdgcn_sched_barrier(0);
        }
        const int R0 = 32 * u;
#pragma unroll
        for (int nt = 0; nt < 2; ++nt) {
            const int n = 64 * X.wave + 32 * nt + r31; const float bg = glu_b[layer * 512 + n];
#pragma unroll
            for (int reg = 0; reg < 16; ++reg) { const int t = crow(reg, h); const size_t row = (size_t)(R0 + t);
                const float gate = sigmoidf_(ga[nt][reg] + bg); const float yv = bf2f(yg[t * YG_LD + n]); const float gc = bf2f(W_Z(X)[row * DIN + C_GC + n]);
                W_MIX(X)[row * DM + 1536 + n] = f2bf(yv * gate * siluf_(gc)); }
        }
        LDS_FENCE(); __syncthreads();
    }
}

DI void attn_item(const Ctx& X, int layer, int it) {
    const int lane = X.lane, r31 = lane & 31, h = lane >> 5;
    const int qt = it & 3, rr = (it >> 2) & 3, g = (it >> 4) & 3, blk = (it >> 6) & 31, b = it >> 11;
    const int head = 4 * g + rr, q0 = blk * 128 + 32 * qt, kbase = q0 - 128;
    const size_t rowb = (size_t)b * 4096;
    bf16x8 qf[4];
#pragma unroll
    for (int ks = 0; ks < 4; ++ks) qf[ks] = *(const bf16x8*)(W_Z(X) + (rowb + q0 + r31) * DIN + C_Q + 64 * head + 16 * ks + 8 * h);
    f32x16 S[5];
#pragma unroll
    for (int kb = 0; kb < 2; ++kb) {
        bf16x8 kf[3][4];
#pragma unroll
        for (int kk = 0; kk < 3; ++kk) { const int kt = 3 * kb + kk; if (kt < 5) {
            int tk = kbase + 32 * kt + r31; tk = tk < 0 ? 0 : tk;
            const bf16_t* kp = W_Z(X) + (rowb + tk) * DIN + C_K + 64 * g + 8 * h;
#pragma unroll
            for (int ks = 0; ks < 4; ++ks) kf[kk][ks] = *(const bf16x8*)(kp + 16 * ks); } }
#pragma unroll
        for (int kk = 0; kk < 3; ++kk) { const int kt = 3 * kb + kk; if (kt < 5) {
            f32x16 s;
#pragma unroll
            for (int i = 0; i < 16; ++i) s[i] = 0.f;
            asm volatile("" : "+v"(s));
#pragma unroll
            for (int ks = 0; ks < 4; ++ks) s = MFMA32(kf[kk][ks], qf[ks], s);
            S[kt] = s; } }
        __builtin_amdgcn_sched_barrier(0);
        asm volatile("s_nop 15\n\ts_nop 15\n\ts_nop 15\n\ts_nop 15\n\ts_nop 15\n\ts_nop 15\n\ts_nop 15\n\ts_nop 15" ::: "memory");
        __builtin_amdgcn_sched_barrier(0);
    }
    const float sink = INP(X, I_SINK)[layer * 16 + head];
    float m = sink;
#pragma unroll
    for (int kt = 0; kt < 5; ++kt)
#pragma unroll
        for (int reg = 0; reg < 16; ++reg) { const int jj = 32 * kt + crow(reg, h), dl = jj - r31; const bool ok = (dl >= 1) && (dl <= 128) && (kbase + jj >= 0);
            const float s = ok ? S[kt][reg] * 0.125f : -1e30f; S[kt][reg] = s; m = fmaxf(m, s); }
    m = fmaxf(m, __shfl_xor(m, 32));
    float sum = 0.f;
#pragma unroll
    for (int kt = 0; kt < 5; ++kt)
#pragma unroll
        for (int reg = 0; reg < 16; ++reg) { const float p = __expf(S[kt][reg] - m); S[kt][reg] = p; sum += p; }
    sum += __shfl_xor(sum, 32); sum += __expf(sink - m);
    const float inv = 1.0f / sum;
    f32x16 O[2];
#pragma unroll
    for (int dt = 0; dt < 2; ++dt)
#pragma unroll
        for (int i = 0; i < 16; ++i) O[dt][i] = 0.f;
    asm volatile("" : "+v"(O[0]), "+v"(O[1]));
#pragma unroll
    for (int kt = 0; kt < 5; ++kt)
#pragma unroll
        for (int s2 = 0; s2 < 2; ++s2) {
            u32x4 pw; pw.x = pk2(S[kt][8 * s2 + 0], S[kt][8 * s2 + 1]); pw.y = pk2(S[kt][8 * s2 + 2], S[kt][8 * s2 + 3]); pw.z = pk2(S[kt][8 * s2 + 4], S[kt][8 * s2 + 5]); pw.w = pk2(S[kt][8 * s2 + 6], S[kt][8 * s2 + 7]);
            const bf16x8 pf = __builtin_bit_cast(bf16x8, pw);
            const int tk = kbase + 32 * kt + 16 * s2 + 4 * h; const int t0 = tk < 0 ? 0 : tk, t1 = (tk + 8) < 0 ? 0 : (tk + 8);
            s16x4 vlo[2], vhi[2];
#pragma unroll
            for (int dt = 0; dt < 2; ++dt) { const bf16_t* vp = W_VT(X) + ((size_t)((b * 4 + g) * 64 + 32 * dt + r31)) * 4096; vlo[dt] = *(const s16x4*)(vp + t0); vhi[dt] = *(const s16x4*)(vp + t1); }
#pragma unroll
            for (int dt = 0; dt < 2; ++dt) {
                const bf16x8 vf = __builtin_shufflevector(vlo[dt], vhi[dt], 0, 1, 2, 3, 4, 5, 6, 7);
                O[dt] = MFMA32(vf, pf, O[dt]);
            }
            __builtin_amdgcn_sched_barrier(0); asm volatile("s_nop 15\n\ts_nop 15\n\ts_nop 15\n\ts_nop 15" ::: "memory"); __builtin_amdgcn_sched_barrier(0);
        }
    const size_t rq = rowb + q0 + r31;
#pragma unroll
    for (int dt = 0; dt < 2; ++dt)
#pragma unroll
        for (int rg = 0; rg < 4; ++rg) {
            const int d0 = 32 * dt + 8 * rg + 4 * h;
            const u32x2 gw2 = *(const u32x2*)(W_Z(X) + rq * DIN + C_GB + 64 * head + d0);
            const float g0 = __uint_as_float(gw2.x << 16), g1 = __uint_as_float(gw2.x & 0xffff0000u), g2 = __uint_as_float(gw2.y << 16), g3 = __uint_as_float(gw2.y & 0xffff0000u);
            u32x2 w; w.x = pk2(O[dt][4 * rg + 0] * inv * siluf_(g0), O[dt][4 * rg + 1] * inv * siluf_(g1)); w.y = pk2(O[dt][4 * rg + 2] * inv * siluf_(g2), O[dt][4 * rg + 3] * inv * siluf_(g3));
            *(u32x2*)(W_MIX(X) + rq * DM + 512 + 64 * head + d0) = w;
        }
}

DI void chunk_item(const Ctx& X, int layer, int it) {
    const int lane = X.lane, r31 = lane & 31, h = lane >> 5;
    const int sub = it & 7, hh = (it >> 3) & 3, chunk = it >> 5, ct = sub & 3, th = sub >> 2;
    const GAS float* chunk_b = INP(X, I_CB);
    const bf16_t* ap = W_VAT(X) + ((size_t)(128 * hh + 32 * ct + r31)) * 8192 + chunk * 128 + 8 * h;
    bf16x8 af[8];
#pragma unroll
    for (int ks = 0; ks < 8; ++ks) af[ks] = *(const bf16x8*)(ap + 16 * ks);
#pragma unroll
    for (int t2 = 0; t2 < 2; ++t2) {
        const int tt = 2 * th + t2, t = 32 * tt + r31;
        const bf16_t* bp = W_WSB(X) + ((size_t)((layer * 4 + hh) * 128 + t)) * 128 + 8 * h;
        f32x16 d;
#pragma unroll
        for (int i = 0; i < 16; ++i) d[i] = 0.f;
        asm volatile("" : "+v"(d));
#pragma unroll
        for (int ks = 0; ks < 8; ++ks) if (ks < 2 * (tt + 1)) d = MFMA32(af[ks], *(const bf16x8*)(bp + 16 * ks), d);
        __builtin_amdgcn_sched_barrier(0); asm volatile("s_nop 15\n\ts_nop 15\n\ts_nop 15\n\ts_nop 15\n\ts_nop 15\n\ts_nop 15" ::: "memory"); __builtin_amdgcn_sched_barrier(0);
        const size_t row = (size_t)chunk * 128 + t; const float bs = chunk_b[(layer * 4 + hh) * 128 + t];
#pragma unroll
        for (int rg = 0; rg < 4; ++rg) {
            const int c0 = 128 * hh + 32 * ct + 8 * rg + 4 * h;
            const u32x2 uw = *(const u32x2*)(W_Z(X) + row * DIN + C_UA + c0), gw2 = *(const u32x2*)(W_Z(X) + row * DIN + C_GA + c0);
            const float u0 = __uint_as_float(uw.x << 16), u1 = __uint_as_float(uw.x & 0xffff0000u), u2 = __uint_as_float(uw.y << 16), u3 = __uint_as_float(uw.y & 0xffff0000u);
            const float g0 = __uint_as_float(gw2.x << 16), g1 = __uint_as_float(gw2.x & 0xffff0000u), g2 = __uint_as_float(gw2.y << 16), g3 = __uint_as_float(gw2.y & 0xffff0000u);
            u32x2 w; w.x = pk2(u0 * (d[4 * rg + 0] + bs) * siluf_(g0), u1 * (d[4 * rg + 1] + bs) * siluf_(g1)); w.y = pk2(u2 * (d[4 * rg + 2] + bs) * siluf_(g2), u3 * (d[4 * rg + 3] + bs) * siluf_(g3));
            *(u32x2*)(W_MIX(X) + row * DM + c0) = w;
        }
    }
}

DI void sample_chunk_item(const Ctx& X, int layer, int it) {
    const int lane = X.lane, seq = it >> 2, hh = it & 3;
    const size_t row0 = 8192 + (size_t)seq * 8;
    const GAS float* chunk_b = INP(X, I_CB); const GAS float* chunk_w = INP(X, I_CW);
#pragma unroll
    for (int cpass = 0; cpass < 2; ++cpass) {
        const int ch = 128 * hh + 64 * cpass + lane;
        float va[8];
#pragma unroll
        for (int s = 0; s < 8; ++s) va[s] = bf2f(W_Z(X)[(row0 + s) * DIN + C_VA + ch]);
#pragma unroll
        for (int t = 0; t < 8; ++t) {
            float a = chunk_b[(layer * 4 + hh) * 128 + t];
#pragma unroll
            for (int s = 0; s < 8; ++s) if (s <= t) a += chunk_w[((size_t)((layer * 4 + hh) * 128 + t)) * 128 + s] * va[s];
            const float uu = bf2f(W_Z(X)[(row0 + t) * DIN + C_UA + ch]), gg = bf2f(W_Z(X)[(row0 + t) * DIN + C_GA + ch]);
            W_MIX(X)[(row0 + t) * DM + ch] = f2bf(uu * a * siluf_(gg));
        }
    }
}

DI void sample_attn_item(const Ctx& X, int layer, int it, LAS float* scr) {
    const int lane = X.lane, seq = it >> 4, head = it & 15, g = head >> 2;
    const size_t row0 = 8192 + (size_t)seq * 8;
    LAS float* Q = scr; LAS float* P = scr + 512;
    const bf16_t* z = W_Z(X);
#pragma unroll
    for (int i = 0; i < 8; ++i) Q[i * 64 + lane] = bf2f(z[(row0 + i) * DIN + C_Q + 64 * head + lane]) * 0.125f;
    LDS_FENCE();
    const float sink = INP(X, I_SINK)[layer * 16 + head];
    const GAS float* cache_k = INP(X, I_CK);
#pragma unroll 1
    for (int rd = 0; rd < 3; ++rd) {
        const int j = 64 * rd + lane;
        float kv[64];
        if (rd < 2) {
            const GAS float* kp = cache_k + (((size_t)(layer * 32 + seq) * 128 + j) * 4 + g) * 64;
#pragma unroll
            for (int d4 = 0; d4 < 16; ++d4) { const f32x4 v = *(const GAS f32x4*)(kp + 4 * d4); kv[4 * d4] = v[0]; kv[4 * d4 + 1] = v[1]; kv[4 * d4 + 2] = v[2]; kv[4 * d4 + 3] = v[3]; }
        } else {
            const int jn = (lane < 8) ? lane : 0;
            const bf16_t* kp = z + (row0 + jn) * DIN + C_K + 64 * g;
#pragma unroll
            for (int d8 = 0; d8 < 8; ++d8) { const u32x4 w = *(const u32x4*)(kp + 8 * d8);
#pragma unroll
                for (int e = 0; e < 4; ++e) { kv[8 * d8 + 2 * e] = __uint_as_float(w[e] << 16); kv[8 * d8 + 2 * e + 1] = __uint_as_float(w[e] & 0xffff0000u); } }
        }
#pragma unroll
        for (int i = 0; i < 8; ++i) {
            float a = 0.f;
#pragma unroll
            for (int d4 = 0; d4 < 16; ++d4) { const f32x4 q = *(const LAS f32x4*)(Q + i * 64 + 4 * d4); a += q[0] * kv[4 * d4] + q[1] * kv[4 * d4 + 1] + q[2] * kv[4 * d4 + 2] + q[3] * kv[4 * d4 + 3]; }
            const int dl = j - i; const bool ok = (j < 136) && (dl >= 1) && (dl <= 128);
            if (j < 136) P[j * 8 + i] = ok ? a : -1e30f;
        }
    }
    LDS_FENCE();
    float inv[8];
#pragma unroll
    for (int i = 0; i < 8; ++i) {
        const float s0 = P[lane * 8 + i], s1 = P[(64 + lane) * 8 + i], s2 = (lane < 8) ? P[(128 + lane) * 8 + i] : -1e30f;
        const float m = fmaxf(wave_max(fmaxf(fmaxf(s0, s1), s2)), sink);
        const float p0 = __expf(s0 - m), p1 = __expf(s1 - m), p2 = (lane < 8) ? __expf(s2 - m) : 0.f;
        inv[i] = 1.0f / (wave_sum(p0 + p1 + p2) + __expf(sink - m));
        P[lane * 8 + i] = p0; P[(64 + lane) * 8 + i] = p1; if (lane < 8) P[(128 + lane) * 8 + i] = p2;
    }
    LDS_FENCE();
    float o[8];
#pragma unroll
    for (int i = 0; i < 8; ++i) o[i] = 0.f;
    const GAS float* vp = INP(X, I_CV) + (((size_t)(layer * 32 + seq) * 128) * 4 + g) * 64 + lane;
#pragma unroll 16
    for (int j = 0; j < 128; ++j) { const float v = vp[(size_t)j * 256]; const f32x4 p0 = *(const LAS f32x4*)(P + j * 8), p1 = *(const LAS f32x4*)(P + j * 8 + 4);
        o[0] += p0[0] * v; o[1] += p0[1] * v; o[2] += p0[2] * v; o[3] += p0[3] * v; o[4] += p1[0] * v; o[5] += p1[1] * v; o[6] += p1[2] * v; o[7] += p1[3] * v; }
#pragma unroll
    for (int jn = 0; jn < 8; ++jn) { const float v = bf2f(z[(row0 + jn) * DIN + C_V + 64 * g + lane]); const f32x4 p0 = *(const LAS f32x4*)(P + (128 + jn) * 8), p1 = *(const LAS f32x4*)(P + (128 + jn) * 8 + 4);
        o[0] += p0[0] * v; o[1] += p0[1] * v; o[2] += p0[2] * v; o[3] += p0[3] * v; o[4] += p1[0] * v; o[5] += p1[1] * v; o[6] += p1[2] * v; o[7] += p1[3] * v; }
#pragma unroll
    for (int i = 0; i < 8; ++i) { const float gb = bf2f(z[(row0 + i) * DIN + C_GB + 64 * head + lane]); W_MIX(X)[(row0 + i) * DM + 512 + 64 * head + lane] = f2bf(o[i] * inv[i] * siluf_(gb)); }
    LDS_FENCE();
}

DI void phase_mixA(const Ctx& X, int layer) {
    LAS float* scr = (LAS float*)(X.lds + X.wave * WSCR);
    constexpr int N_ATT = 4096, N_CH = 2048, N_SA = 512, N_SC = 128, N_S5 = 2048;
    for (int it = X.gw; it < N_S5; it += X.ngw) s5_wave_unit<false>(X, layer, it >> 3, it & 7, scr, nullptr);
    for (int it = X.gw; it < N_SA; it += X.ngw) sample_attn_item(X, layer, it, scr);
    for (int it = X.gw; it < N_SC; it += X.ngw) sample_chunk_item(X, layer, it);
    if (gridDim.x >= 72 && blockIdx.x >= 64 && blockIdx.x < 72) { asm volatile("s_waitcnt vmcnt(0) lgkmcnt(0)" ::: "memory"); __syncthreads(); phase_s5c(X, layer, 256 + (int)blockIdx.x - 64, 264); }
    else if (gridDim.x < 72) { asm volatile("s_waitcnt vmcnt(0) lgkmcnt(0)" ::: "memory"); __syncthreads(); phase_s5c(X, layer, 256 + (int)blockIdx.x, 264); }
    if (gridDim.x == 256 && blockIdx.x >= 72 && layer + 1 < NLAYER) { asm volatile("s_waitcnt vmcnt(0) lgkmcnt(0)" ::: "memory"); convert_layer_weights(X, layer + 1, X.gw - 72 * NWAVES, (256 - 72) * NWAVES); }
}

DI void phase_carry(const Ctx& X, int layer) {
    const int lane = X.lane;
    for (int it = X.gw; it < 64; it += X.ngw) {
        const int b = it >> 5, g = it & 31, lg = layer * 32 + g;
        const float2 aT = W_AT(X)[lg * 64 + lane];
        const float2* Ep = W_E(X) + ((size_t)(b * 128) * 32 + g) * 64 + lane;
        float2* Hp = W_H0(X) + ((size_t)(b * 128) * 32 + g) * 64 + lane;
        float hr = 0.f, hi = 0.f;
        for (int c = 0; c < 128; c += 16) {
            float2 e[16];
#pragma unroll
            for (int j = 0; j < 16; ++j) e[j] = Ep[(size_t)(c + j) * 2048];
#pragma unroll
            for (int j = 0; j < 16; ++j) { Hp[(size_t)(c + j) * 2048] = make_float2(hr, hi); const float nr = aT.x * hr - aT.y * hi + e[j].x, ni = aT.x * hi + aT.y * hr + e[j].y; hr = nr; hi = ni; }
        }
    }
}

DI void phase_final(const Ctx& X) {
    const GAS float* final_g = INP(X, I_FG);
    for (int m = X.gw; m < MROWS; m += X.ngw) {
        const float rs = rsqrtf((float)W_ROWSS(X)[4 * MROWS + m] * (2.3283064365386963e-10f / 2048.0f) + 1e-5f);
#pragma unroll
        for (int j = 0; j < 8; ++j) { const int c = 4 * X.lane + 256 * j; const f32x4 v = *(const f32x4*)(W_XRES(X) + (size_t)m * DM + c); const f32x4 gg = *(const GAS f32x4*)(final_g + c);
            *(f32x4*)(X.out + OFF_Y + (size_t)m * DM + c) = v * rs * gg; }
    }
}

#define XB_TMO      128
#define XB_XCNT(j)  (256  + 64 * (j))
#define XB_XSUB(j)  (1280 + 64 * (j))
#define XB_XGEN(j)  (2304 + 64 * (j))
#define XB_TOP      3328
#define XB_TOPGEN   3392
#define XCD_BAR_WORDS 3456
#define XB_SPIN_CAP (1u << 18)

__device__ __forceinline__ unsigned xb_ld(unsigned* p)              { return __hip_atomic_load(p, __ATOMIC_RELAXED, __HIP_MEMORY_SCOPE_AGENT); }
__device__ __forceinline__ unsigned xb_add(unsigned* p, unsigned v) { return __hip_atomic_fetch_add(p, v, __ATOMIC_RELAXED, __HIP_MEMORY_SCOPE_AGENT); }
__device__ __forceinline__ unsigned xb_xcc_id() { return (unsigned)__builtin_amdgcn_s_getreg((3 << 11) | 20) & 0xFu; }
#define XB_SPIN(cond, bar) do { unsigned _sp = 0; while (cond) { __builtin_amdgcn_s_sleep(1); \
    if ((++_sp & 255u) == 0u) { if (xb_ld(&(bar)[XB_TMO])) break; if (_sp > XB_SPIN_CAP) { atomicAdd(&(bar)[XB_TMO], 1u); break; } } } } while (0)

struct XcdBarrier {
    unsigned* bar; unsigned x;
    volatile LAS unsigned* st;
};

__device__ __forceinline__ XcdBarrier xcd_barrier_post(unsigned* bar, volatile LAS unsigned* st) {
    XcdBarrier b; b.bar = bar; b.x = xb_xcc_id(); b.st = st;
    if (threadIdx.x == 0) (void)xb_add(&bar[XB_XCNT(b.x)], 1u);
    return b;
}
__device__ __forceinline__ void xcd_barrier_complete(unsigned* bar, unsigned x, unsigned& nloc, unsigned& nx) {
    const unsigned G = gridDim.x * gridDim.y * gridDim.z;
    unsigned sum, cnt, mine, sp = 0u;
    for (;;) {
        sum = 0u; cnt = 0u; mine = 0u;
#pragma unroll
        for (unsigned j = 0; j < 16; ++j) { const unsigned c = xb_ld(&bar[XB_XCNT(j)]); sum += c; cnt += (c > 0u) ? 1u : 0u; mine = (j == x) ? c : mine; }
        if (sum == G) break;
        __builtin_amdgcn_s_sleep(1);
        if ((++sp & 255u) == 0u) { if (xb_ld(&bar[XB_TMO])) break; if (sp > XB_SPIN_CAP) { atomicAdd(&bar[XB_TMO], 1u); break; } }
    }
    nloc = mine > 0u ? mine : 1u; nx = cnt > 0u ? cnt : 1u;
}

__device__ __forceinline__ void xcd_barrier(const XcdBarrier& b) {
    asm volatile("s_waitcnt vmcnt(0)" ::: "memory");
    __syncthreads();
    if (threadIdx.x == 0) {
        unsigned* bar = b.bar;
        __builtin_amdgcn_s_waitcnt(0);
        unsigned nloc = b.st[0], nx = b.st[1];
        if (nloc == 0u) { xcd_barrier_complete(bar, b.x, nloc, nx); b.st[0] = nloc; b.st[1] = nx; }
        const unsigned old = xb_add(&bar[XB_XSUB(b.x)], 1u);
        const unsigned gen = old / nloc;
        if (old + 1u == (gen + 1u) * nloc) {
            __builtin_amdgcn_fence(__ATOMIC_RELEASE, "agent");
            asm volatile("s_waitcnt vmcnt(0)" ::: "memory");
            const unsigned og = xb_add(&bar[XB_TOP], 1u);
            const unsigned tg = og / nx;
            if (og + 1u == (tg + 1u) * nx) xb_add(&bar[XB_TOPGEN], 1u);
            else XB_SPIN(xb_ld(&bar[XB_TOPGEN]) == tg, bar);
            __builtin_amdgcn_fence(__ATOMIC_ACQUIRE, "agent");
            xb_add(&bar[XB_XGEN(b.x)], 1u);
            asm volatile("s_waitcnt vmcnt(0)" ::: "memory");
        } else {
            XB_SPIN(xb_ld(&bar[XB_XGEN(b.x)]) == gen, bar);
            __builtin_amdgcn_fence(__ATOMIC_ACQUIRE, "agent");
            asm volatile("s_waitcnt vmcnt(0)" ::: "memory");
        }
    }
    __syncthreads();
}

struct Args { const float* in[23]; float* out; unsigned char* ws; int ph_lo, ph_hi; };
constexpr int N_PHASES = 2 + 5 * NLAYER;

__global__ void __launch_bounds__(NTHREADS, 2) fwd_megakernel(Args a) {
    extern __shared__ __attribute__((aligned(16))) unsigned char lds_raw[];
    Ctx X0;
    X0.lds = (LAS unsigned char*)lds_raw;
    X0.lane = threadIdx.x & 63; X0.wave = __builtin_amdgcn_readfirstlane(threadIdx.x >> 6);
    X0.gw = blockIdx.x * NWAVES + X0.wave; X0.ngw = gridDim.x * NWAVES;
    X0.out = a.out; X0.ws = a.ws;
    if (threadIdx.x < 23) *(LAS unsigned long long*)(X0.lds + PTR_OFF + 8 * threadIdx.x) = (unsigned long long)a.in[threadIdx.x];
    if (threadIdx.x == 0) { *(volatile LAS unsigned*)(X0.lds + XB_LDS_OFF) = 0u; *(volatile LAS unsigned*)(X0.lds + XB_LDS_OFF + 4) = 0u; }
    LDS_FENCE(); __syncthreads();
    XcdBarrier xbar = xcd_barrier_post((unsigned*)(a.ws + WS_XBAR), (volatile LAS unsigned*)(X0.lds + XB_LDS_OFF));

    for (int ph = a.ph_lo; ph < a.ph_hi; ++ph) {
        if (ph > a.ph_lo) {
            if (ph == a.ph_lo + 1) {
                asm volatile("s_waitcnt vmcnt(0) lgkmcnt(0)" ::: "memory");
                __builtin_amdgcn_fence(__ATOMIC_RELEASE, "agent");
                asm volatile("s_waitcnt vmcnt(0)" ::: "memory");
                __syncthreads();
                cg::this_grid().sync();
                __builtin_amdgcn_fence(__ATOMIC_ACQUIRE, "agent");
                asm volatile("s_waitcnt vmcnt(0)" ::: "memory");
                __syncthreads();
            } else {
                asm volatile("s_waitcnt vmcnt(0) lgkmcnt(0)" ::: "memory");
                xcd_barrier(xbar);
            }
        } else { __builtin_amdgcn_fence(__ATOMIC_ACQUIRE, "agent"); asm volatile("s_waitcnt vmcnt(0)" ::: "memory"); __syncthreads(); }
        Ctx X = X0;
        asm volatile("" : "+v"(X.lane), "+s"(X.wave), "+s"(X.gw), "+s"(X.ngw));
        if (ph == 100) { for (int i = X.gw * 64 + X.lane; i < MROWS * 512; i += X.ngw * 64) X.out[i] = bf2f(W_Z(X)[(size_t)(i >> 9) * DIN + C_UC + (i & 511)]); }
        else if (ph == 101) { for (int i = X.gw * 64 + X.lane; i < 2 * 128 * 32 * 64 * 2; i += X.ngw * 64) X.out[8 * 1024 * 1024 + i] = ((const float*)W_E(X))[i]; }
        else if (ph == 0) phase_prologue(X);
        else if (ph == N_PHASES - 1) phase_final(X);
        else {
            const int l = (ph - 1) / 5, k = (ph - 1) % 5;
            if (k == 0) {
                pg8::Gemm g{W_XB(X), W_WIT(X) + (size_t)l * DIN * DM, MROWS, DIN, DM}; pg8::StaticOrder S; S.init(MROWS, DIN, (int)gridDim.x, (int)blockIdx.x);
                pg8::EpiIn E{X.ws, X.out, l};
                pg8::gemm_phase<pg8::EpiIn, pg8::StaticOrder, true, true>(X.lds, g, S, E);
            } else if (k == 1) phase_mixA(X, l);
            else if (k == 2) {
                phase_carry(X, l);
                if (X.ngw == 2048) {
                    if (X.gw < 1984) { attn_item(X, l, X.gw); attn_item(X, l, X.gw + 1984); if (X.gw >= 1000 && X.gw < 1128) attn_item(X, l, 3968 + X.gw - 1000); }
                } else for (int it = X.gw; it < 4096; it += X.ngw) attn_item(X, l, it);
                for (int it = X.gw; it < 2048; it += X.ngw) chunk_item(X, l, it);
                if (gridDim.x >= 16 && gridDim.x != 256 && blockIdx.x < gridDim.x - 8 && l + 1 < NLAYER) { asm volatile("s_waitcnt vmcnt(0) lgkmcnt(0)" ::: "memory"); convert_layer_weights(X, l + 1, X.gw, (int)(gridDim.x - 8) * NWAVES); }
                if (gridDim.x >= 16 && blockIdx.x >= gridDim.x - 8) {
                    asm volatile("s_waitcnt vmcnt(0) lgkmcnt(0)" ::: "memory"); __syncthreads();
                    pg8::Gemm g{W_MIX(X), W_WOT(X) + (size_t)l * DM * DM, MROWS, DM, DM}; pg8::SampleOrder S{(int)blockIdx.x, (int)gridDim.x};
                    pg8::EpiOut E{l == 0 ? (const float*)INP(X, I_XP) : (const float*)W_XRES(X), l == 0 ? (const float*)INP(X, I_XS) : (const float*)(W_XRES(X) + (size_t)8192 * DM), X.ws, l};
                    pg8::gemm_phase<pg8::EpiOut, pg8::SampleOrder, true, true>(X.lds, g, S, E);
                }
            }
            else if (k == 3) phase_s5c(X, l, (int)blockIdx.x, 256);
            else {
                pg8::Gemm g{W_MIX(X), W_WOT(X) + (size_t)l * DM * DM, MROWS, DM, DM}; pg8::StaticOrder S; S.init(gridDim.x >= 16 ? MPROMPT : MROWS, DM, (int)gridDim.x, (int)blockIdx.x);
                pg8::EpiOut E{l == 0 ? (const float*)INP(X, I_XP) : (const float*)W_XRES(X), l == 0 ? (const float*)INP(X, I_XS) : (const float*)(W_XRES(X) + (size_t)8192 * DM), X.ws, l};
                pg8::gemm_phase<pg8::EpiOut, pg8::StaticOrder, true, true>(X.lds, g, S, E);
            }
        }
    }
    asm volatile("s_waitcnt vmcnt(0)" ::: "memory"); __builtin_amdgcn_fence(__ATOMIC_RELEASE, "agent"); asm volatile("s_waitcnt vmcnt(0)" ::: "memory");
}

extern "C" void kernel_launch(void* const* d_in, const int* in_sizes, int n_in, void* d_out, int out_size, void* d_ws, size_t ws_size, hipStream_t stream) {
    static int grid = 0;
    if (grid == 0) {
        if (n_in != 23 || (size_t)out_size != OUT_TOTAL || ws_size < WS_END) { fprintf(stderr, "kernel_launch: unexpected shapes (n_in %d, out %d, ws %zu); nothing launched\n", n_in, out_size, ws_size); grid = -1; return; }
        int dev = 0, cus = 0, per_cu = 0;
        if (hipGetDevice(&dev) != hipSuccess || hipDeviceGetAttribute(&cus, hipDeviceAttributeMultiprocessorCount, dev) != hipSuccess) { grid = -1; return; }
        if (hipFuncSetAttribute((const void*)fwd_megakernel, hipFuncAttributeMaxDynamicSharedMemorySize, LDS_BYTES) != hipSuccess) { fprintf(stderr, "kernel_launch: hipFuncSetAttribute failed\n"); grid = -1; return; }
        if (hipOccupancyMaxActiveBlocksPerMultiprocessor(&per_cu, (const void*)fwd_megakernel, NTHREADS, LDS_BYTES) != hipSuccess || per_cu < 1) { fprintf(stderr, "kernel_launch: occupancy query says %d blocks/CU\n", per_cu); per_cu = 1; }
        (void)hipGetLastError();
        grid = cus;
    }
    if (grid < 0) return;
    if (hipMemsetAsync((char*)d_ws + WS_CTL, 0, CTL_ZERO_BYTES, stream) != hipSuccess) { fprintf(stderr, "kernel_launch: memset failed\n"); return; }
    Args a{};
    for (int i = 0; i < 23; ++i) a.in[i] = (const float*)d_in[i];
    a.out = (float*)d_out; a.ws = (unsigned char*)d_ws;
#if N_LAUNCH_MODE == 1
    a.ph_lo = 0; a.ph_hi = N_PHASES;
    void* args[] = {&a};
    hipError_t e = hipLaunchCooperativeKernel((const void*)fwd_megakernel, dim3(grid), dim3(NTHREADS), args, LDS_BYTES, stream);
    if (e != hipSuccess) fprintf(stderr, "kernel_launch: cooperative launch failed: %s (grid %d)\n", hipGetErrorString(e), grid);
#else
#ifndef DBG_MAX_PH
#define DBG_MAX_PH N_PHASES
#endif
    for (int ph = 0; ph < DBG_MAX_PH; ++ph) {
        a.ph_lo = ph; a.ph_hi = ph + 1;
        hipLaunchKernelGGL(fwd_megakernel, dim3(grid), dim3(NTHREADS), LDS_BYTES, stream, a);
    }
#ifdef DBG_DUMP
    a.ph_lo = DBG_DUMP; a.ph_hi = DBG_DUMP + 1; hipLaunchKernelGGL(fwd_megakernel, dim3(grid), dim3(NTHREADS), LDS_BYTES, stream, a);
#endif
#endif
}
```

```cpp
#include <hip/hip_runtime.h>
#include <hip/hip_cooperative_groups.h>
#include <cstdio>
#include <cstdint>
namespace cg = cooperative_groups;

#ifndef N_LAUNCH_MODE
#define N_LAUNCH_MODE 1
#endif

constexpr int DM = 2048, DIN = 5120, MROWS = 8448, MPROMPT = 8192, NLAYER = 4;
constexpr int C_UA = 0, C_VA = 512, C_GA = 1024, C_Q = 1536, C_K = 2560, C_V = 2816, C_GB = 3072, C_UC = 4096, C_GC = 4608;
constexpr size_t OFF_Y = 0, OFF_KP = 17301504, OFF_VP = 17563648, OFF_KS = 17825792, OFF_VS = 18087936,
                 OFF_HRP = 18350080, OFF_HIP = 18366464, OFF_HRS = 18382848, OFF_HIS = 18644992, OFF_VA = 18907136, OUT_TOTAL = 19431424;
constexpr size_t MiB = 1u << 20;
constexpr size_t WS_CTL = 0, CTL_ZERO_BYTES = 1 * MiB, WS_ROWSS = 65536;
constexpr size_t WS_AB = 1 * MiB, WS_AT = WS_AB + 65536, WS_BB = WS_AT + 65536, WS_CC = WS_BB + 524288, WS_ROPE = WS_CC + 524288, WS_WSB = WS_ROPE + 262656 + 1472  ;
constexpr size_t WS_WGT = 4 * MiB, WS_WOT = 6 * MiB, WS_WIT = 38 * MiB, WS_XB = 118 * MiB, WS_XRES = 151 * MiB, WS_Z = 217 * MiB,
                 WS_MIX = 300 * MiB, WS_VT = 333 * MiB, WS_VAT = 337 * MiB, WS_E = 345 * MiB, WS_H0 = 349 * MiB, WS_END = 353 * MiB;
static_assert(WS_WSB + 524288 <= WS_WGT, "tables fit");
static_assert(WS_WSB % 16 == 0, "align");

namespace pg8 {
#define PG8_LAS __attribute__((address_space(3)))
typedef unsigned short bf16_t;
typedef short bf16x8 __attribute__((ext_vector_type(8)));
typedef float f32x4 __attribute__((ext_vector_type(4)));
typedef unsigned u32x4 __attribute__((ext_vector_type(4)));
typedef unsigned u32x2 __attribute__((ext_vector_type(2)));
constexpr int BM = 256, BK = 64, HALF = 128, HTB = HALF * BK * 2  , STAGE_BYTES = 8 * HTB, NXCD = 8, WGM = 8;
__host__ __device__ __forceinline__ int lds_byte(int r, int c) { const int st = (r >> 4) * 2 + (c >> 5), rr = r & 15, cc = c & 31, ob = rr * 64 + cc * 2; return st * 1024 + (ob ^ (((ob >> 9) & 1) << 5)); }
__host__ __device__ __forceinline__ void stage_rc(int b, int& R, int& C) { const int st = b / 1024, sb = b % 1024, swz = sb ^ (((sb >> 9) & 1) << 5); R = (st >> 1) * 16 + swz / 64; C = (st & 1) * 32 + (swz % 64) / 2; }
__host__ __device__ __forceinline__ int perm32(int rho) { const int n = rho >> 4, i = rho & 15; return 8 * (i >> 2) + 4 * n + (i & 3); }

struct Unit { int pm, pn; };
struct Gemm { const bf16_t* A; const bf16_t* Bt; int M, N, K; };

struct StaticOrder {
    int nM, nN, nwg, G, c;
    __host__ __device__ void init(int M, int N, int G_, int c_) { nM = M / BM; nN = N / BM; nwg = nM * nN; G = G_; c = c_; }
    __host__ __device__ bool next(int i, Unit& u) const {
        const long L = (long)i * G + c; if (L >= nwg) return false;
        int wgid = (int)L; { const int q = nwg / NXCD, r = nwg % NXCD, xcd = wgid % NXCD, off = wgid / NXCD; wgid = (xcd < r ? xcd * (q + 1) : r * (q + 1) + (xcd - r) * q) + off; }
        const int nig = WGM * nN, gid = wgid / nig, fm = gid * WGM, gsz = (nM - fm) < WGM ? (nM - fm) : WGM;
        u.pm = fm + ((wgid % nig) % gsz); u.pn = (wgid % nig) / gsz; return true;
    }
    __device__ __forceinline__ void a_ready(const Unit&) const {}
    __device__ __forceinline__ void done(const Unit&) const {}
};

struct SampleOrder {
    int c, G;
    __device__ __forceinline__ bool next(int i, Unit& u) const { if (i != 0 || c < G - 8) return false; u.pm = 32; u.pn = c - (G - 8); return true; }
    __device__ __forceinline__ void a_ready(const Unit&) const {}
    __device__ __forceinline__ void done(const Unit&) const {}
};
typedef __bf16 bf16x2_t __attribute__((ext_vector_type(2)));
typedef float f32x2_t __attribute__((ext_vector_type(2)));
__device__ __forceinline__ unsigned pk2(float lo, float hi) { f32x2_t v = {lo, hi}; bf16x2_t b = __builtin_convertvector(v, bf16x2_t); return __builtin_bit_cast(unsigned, b); }
__device__ __forceinline__ bf16_t f2bf(float f) { return (bf16_t)(pk2(f, 0.f) & 0xffffu); }
__device__ __forceinline__ float bf2f(bf16_t h) { return __uint_as_float(((unsigned)h) << 16); }

struct EpiIn {
    static constexpr bool PERM = true, AFTER_DRAIN = false;
    unsigned char* ws; float* out; int layer;
    __device__ __forceinline__ void operator()(const f32x4 (&acc)[2][2][4][2], const Unit& u, int wr, int wc, int fr_, int fq_) const {
        int lane_ = threadIdx.x & 63; asm volatile("" : "+v"(lane_));
        const int fr = lane_ & 15, fq = lane_ >> 4;
        const int pn = u.pn, pm = u.pm;
        bf16_t* z = (bf16_t*)(ws + WS_Z); const unsigned long long* rowss = (const unsigned long long*)(ws + WS_ROWSS) + layer * MROWS; const float2* rope = (const float2*)(ws + WS_ROPE);
        bf16_t* vT = (bf16_t*)(ws + WS_VT); bf16_t* vaT = (bf16_t*)(ws + WS_VAT);
        const bool is_rope = (pn >= 6 && pn <= 10) && ((wc & 1) == 0);
#pragma unroll
        for (int ai = 0; ai < 2; ++ai)
#pragma unroll
            for (int m = 0; m < 4; ++m) {
                const int r = pm * BM + ai * HALF + wr * 64 + m * 16 + fr;
                const float rs = rsqrtf((float)rowss[r] * (2.3283064365386963e-10f / 2048.0f) + 1e-5f);
                const int pi = (r < 8192) ? (r & 4095) : (4096 + ((r - 8192) & 7));
#pragma unroll
                for (int bj = 0; bj < 2; ++bj) {
                    f32x4 v0 = acc[ai][bj][m][0] * rs, v1 = acc[ai][bj][m][1] * rs;
                    const int c = pn * BM + bj * HALF + wc * 32 + 8 * fq;
                    if (is_rope) {
                        f32x4 p0, p1;
#pragma unroll
                        for (int e = 0; e < 4; ++e) { p0[e] = __shfl_xor(v0[e], 16); p1[e] = __shfl_xor(v1[e], 16); }
                        if (fq < 2) {
                            const float2* cs = rope + (size_t)pi * 8;
                            const float sg = (fq == 0) ? -1.0f : 1.0f;
#pragma unroll
                            for (int e = 0; e < 4; ++e) {
                                const float2 c0 = cs[e], c1 = cs[4 + e];
                                v0[e] = v0[e] * c0.x + sg * p0[e] * c0.y;
                                v1[e] = v1[e] * c1.x + sg * p1[e] * c1.y;
                            }
                        }
                    }
                    u32x4 w; w.x = pk2(v0[0], v0[1]); w.y = pk2(v0[2], v0[3]); w.z = pk2(v1[0], v1[1]); w.w = pk2(v1[2], v1[3]);
                    *(u32x4*)(z + (size_t)r * DIN + c) = w;
                    if (pn == 10 || pn == 11) {
                        const int cc = c - pn * BM;
                        float* o = nullptr;
                        if (pm == 32) o = out + (pn == 10 ? OFF_KS : OFF_VS) + ((size_t)(layer * 256 + (r - 8192))) * 256 + cc;
                        else if ((pm & 15) == 15 && ai == 1) o = out + (pn == 10 ? OFF_KP : OFF_VP) + ((size_t)((layer * 2 + (pm >> 4)) * 128 + ((r & 4095) - 3968))) * 256 + cc;
                        if (o) { *(f32x4*)o = v0; *(f32x4*)(o + 4) = v1; }
                        if (pn == 11 && pm < 32) {
                            const int b = r >> 12, t = r & 4095;
                            bf16_t* vp = vT + ((size_t)(b * 256 + cc)) * 4096 + t;
#pragma unroll
                            for (int e = 0; e < 8; ++e) vp[(size_t)e * 4096] = (bf16_t)((w[e >> 1] >> (16 * (e & 1))) & 0xffffu);
                        }
                    }
                    if (pn == 2 || pn == 3) {
                        const int ch = c - C_VA;
                        if (pm < 32) {
                            bf16_t* vp = vaT + (size_t)ch * 8192 + r;
#pragma unroll
                            for (int e = 0; e < 8; ++e) vp[(size_t)e * 8192] = (bf16_t)((w[e >> 1] >> (16 * (e & 1))) & 0xffffu);
                        } else {
                            float* o = out + OFF_VA + ((size_t)(layer * 256 + (r - 8192))) * 512 + ch;
                            *(f32x4*)o = v0; *(f32x4*)(o + 4) = v1;
                        }
                    }
                }
            }
    }
};

struct EpiOut {
    static constexpr bool PERM = false, AFTER_DRAIN = false;
    const float* xp; const float* xs; unsigned char* ws; int layer;
    __device__ __forceinline__ void operator()(const f32x4 (&acc)[2][2][4][2], const Unit& u, int wr, int wc, int fr_, int fq_) const {
        int lane_ = threadIdx.x & 63; asm volatile("" : "+v"(lane_));
        const int fr = lane_ & 15, fq = lane_ >> 4;
        float* xres = (float*)(ws + WS_XRES); bf16_t* xb = (bf16_t*)(ws + WS_XB); unsigned long long* rowss_next = (unsigned long long*)(ws + WS_ROWSS) + (layer + 1) * MROWS;
#pragma unroll
        for (int ai = 0; ai < 2; ++ai)
#pragma unroll
            for (int m = 0; m < 4; ++m) {
                const int r = u.pm * BM + ai * HALF + wr * 64 + m * 16 + fr;
                const float* xo = (r < 8192) ? (xp + (size_t)r * DM) : (xs + (size_t)(r - 8192) * DM);
                float ss = 0.f;
#pragma unroll
                for (int bj = 0; bj < 2; ++bj)
#pragma unroll
                    for (int n = 0; n < 2; ++n) {
                        const int c = u.pn * BM + bj * HALF + wc * 32 + 16 * n + 4 * fq;
                        const f32x4 o = *(const f32x4*)(xo + c) + acc[ai][bj][m][n];
                        *(f32x4*)(xres + (size_t)r * DM + c) = o;
                        u32x2 w; w.x = pk2(o[0], o[1]); w.y = pk2(o[2], o[3]);
                        *(u32x2*)(xb + (size_t)r * DM + c) = w;
                        ss += (o[0] * o[0] + o[1] * o[1]) + (o[2] * o[2] + o[3] * o[3]);
                    }
                ss += __shfl_xor(ss, 16); ss += __shfl_xor(ss, 32);
                if (fq == 0) atomicAdd(rowss_next + r, (unsigned long long)(ss * 4294967296.0f));
                asm volatile("" ::: "memory");
            }
    }
};

template <class Epi, class Sched, bool ALIGN_EPI = false, bool SP2 = false>
__device__ __forceinline__ void gemm_phase(PG8_LAS unsigned char* lds, const Gemm g, const Sched& S, const Epi& E) {
    int tid_ = threadIdx.x; asm volatile("" : "+v"(tid_));
    const int tid = tid_, wid = __builtin_amdgcn_readfirstlane(tid >> 6), lane = tid & 63, wr = wid >> 2, wc = wid & 3, fr = lane & 15, fq = lane >> 4;
    const int K = g.K, nt = K / BK;
    unsigned voffA[2], voffB[2];
#pragma unroll
    for (int i = 0; i < 2; ++i) { int R, C; stage_rc(tid * 16 + i * 8192, R, C); const int Rb = Epi::PERM ? ((R & ~31) + perm32(R & 31)) : R;
        voffA[i] = (unsigned)(R * K + C) * 2u; voffB[i] = (unsigned)(Rb * K + C) * 2u; }
    const size_t kstep = (size_t)(BK * 2);
    const size_t hstep = (size_t)HALF * K * 2;
    const size_t tstep = 2 * hstep;
    const unsigned ldsw = (unsigned)wid * 1024u;
    const int aoff = lds_byte(wr * 64 + fr, fq * 8), boff = lds_byte(wc * 32 + fr, fq * 8);
#define PG8_SA(b, h) (((b) * 2 + (h)) * HTB)
#define PG8_SB(b, h) ((4 + (b) * 2 + (h)) * HTB)
#define PG8_STAGE(bufoff, gbase, voff) do { _Pragma("unroll") for (int _i = 0; _i < 2; ++_i) \
        __builtin_amdgcn_global_load_lds((const unsigned*)((const char*)(gbase) + (voff)[_i]), (PG8_LAS unsigned*)(lds + (bufoff) + ldsw + _i * 8192), 16, 0, 0); } while (0)
#define PG8_LDA(dst, b, h) do { _Pragma("unroll") for (int m = 0; m < 4; ++m) _Pragma("unroll") for (int k = 0; k < 2; ++k) dst[m][k] = *(const PG8_LAS bf16x8*)(lds + PG8_SA(b, h) + aoff + m * 2048 + k * 1024); } while (0)
#define PG8_LDB(dst, b, h) do { _Pragma("unroll") for (int n = 0; n < 2; ++n) _Pragma("unroll") for (int k = 0; k < 2; ++k) dst[n][k] = *(const PG8_LAS bf16x8*)(lds + PG8_SB(b, h) + boff + n * 2048 + k * 1024); } while (0)
#define PG8_MMA(ai, bj, At, Bt) do { __builtin_amdgcn_s_setprio(1); _Pragma("unroll") for (int m = 0; m < 4; ++m) _Pragma("unroll") for (int n = 0; n < 2; ++n) _Pragma("unroll") for (int k = 0; k < 2; ++k) \
        acc[ai][bj][m][n] = __builtin_amdgcn_mfma_f32_16x16x32_bf16(Bt[n][k], At[m][k], acc[ai][bj][m][n], 0, 0, 0); __builtin_amdgcn_s_setprio(0); } while (0)
#define PG8_WAIT_V(n) asm volatile("s_waitcnt vmcnt(" #n ")" ::: "memory")
#define PG8_WAIT_L(n) asm volatile("s_waitcnt lgkmcnt(" #n ")" ::: "memory")
#define PG8_BAR __builtin_amdgcn_s_barrier()
#define PG8_SCHED __builtin_amdgcn_sched_barrier(0)
    Unit cur, nxt; int ui = 0;
    if (!S.next(0, cur)) return;
    f32x4 acc[2][2][4][2];
#pragma unroll
    for (int a = 0; a < 2; ++a)
#pragma unroll
        for (int b = 0; b < 2; ++b)
#pragma unroll
            for (int m = 0; m < 4; ++m)
#pragma unroll
                for (int n = 0; n < 2; ++n) acc[a][b][m][n] = (f32x4){0.f, 0.f, 0.f, 0.f};
    bf16x8 At[4][2], B0[2][2], B1[2][2];
    const char* cA = (const char*)g.A + (size_t)cur.pm * tstep; const char* cB = (const char*)g.Bt + (size_t)cur.pn * tstep;
    S.a_ready(cur);
    if constexpr (SP2) {
        PG8_STAGE(PG8_SB(0, 0), cB, voffB); PG8_STAGE(PG8_SB(0, 1), cB + hstep, voffB); PG8_STAGE(PG8_SA(0, 0), cA, voffA); PG8_STAGE(PG8_SA(0, 1), cA + hstep, voffA);
        if (wr == 1) PG8_BAR;
        PG8_WAIT_V(2); PG8_BAR;
        PG8_STAGE(PG8_SB(1, 0), cB + kstep, voffB); PG8_STAGE(PG8_SA(1, 0), cA + kstep, voffA); PG8_STAGE(PG8_SB(1, 1), cB + hstep + kstep, voffB);
        PG8_WAIT_V(6); PG8_BAR;
    } else {
        PG8_STAGE(PG8_SB(0, 0), cB, voffB); PG8_STAGE(PG8_SA(0, 0), cA, voffA); PG8_STAGE(PG8_SB(0, 1), cB + hstep, voffB); PG8_STAGE(PG8_SA(0, 1), cA + hstep, voffA);
        if (wr == 1) PG8_BAR;
        PG8_WAIT_V(4); PG8_BAR;
        PG8_STAGE(PG8_SB(1, 0), cB + kstep, voffB); PG8_STAGE(PG8_SA(1, 0), cA + kstep, voffA); PG8_STAGE(PG8_SB(1, 1), cB + hstep + kstep, voffB);
        PG8_WAIT_V(6); PG8_BAR;
    }
    for (;;) {
        const bool has_next = S.next(ui + 1, nxt);
        const char* nA = has_next ? (const char*)g.A + (size_t)nxt.pm * tstep : cA; const char* nB = has_next ? (const char*)g.Bt + (size_t)nxt.pn * tstep : cB;
        for (int t = 0; t < nt; t += 2) {
            const bool last = (t == nt - 2);
            const char* a1 = cA + (size_t)(t + 1) * kstep;
            const char* a2 = last ? nA : cA + (size_t)(t + 2) * kstep; const char* b2 = last ? nB : cB + (size_t)(t + 2) * kstep;
            const char* a3 = a2 + kstep; const char* b3 = b2 + kstep;
            if (last && has_next) S.a_ready(nxt);
            if constexpr (SP2) {
            PG8_LDB(B0, 0, 0); PG8_LDB(B1, 0, 1); PG8_SCHED; PG8_LDA(At, 0, 0); PG8_STAGE(PG8_SA(1, 1), a1 + hstep, voffA);
            PG8_WAIT_V(8); PG8_WAIT_L(0); PG8_BAR; PG8_MMA(0, 0, At, B0); PG8_MMA(0, 1, At, B1); PG8_BAR; PG8_SCHED;
            PG8_LDA(At, 0, 1); PG8_STAGE(PG8_SB(0, 0), b2, voffB); PG8_STAGE(PG8_SB(0, 1), b2 + hstep, voffB); PG8_STAGE(PG8_SA(0, 0), a2, voffA);
            PG8_WAIT_V(8); PG8_WAIT_L(0); PG8_BAR; PG8_MMA(1, 0, At, B0); PG8_MMA(1, 1, At, B1); PG8_BAR; PG8_SCHED;
            PG8_LDB(B0, 1, 0); PG8_LDB(B1, 1, 1); PG8_SCHED; PG8_LDA(At, 1, 0); PG8_STAGE(PG8_SA(0, 1), a2 + hstep, voffA);
            PG8_WAIT_V(8); PG8_WAIT_L(0); PG8_BAR; PG8_MMA(0, 0, At, B0); PG8_MMA(0, 1, At, B1); PG8_BAR; PG8_SCHED;
            PG8_LDA(At, 1, 1); PG8_STAGE(PG8_SB(1, 0), b3, voffB); PG8_STAGE(PG8_SB(1, 1), b3 + hstep, voffB); PG8_STAGE(PG8_SA(1, 0), a3, voffA);
            PG8_WAIT_V(8); PG8_WAIT_L(0); PG8_BAR; PG8_MMA(1, 0, At, B0); PG8_MMA(1, 1, At, B1); PG8_BAR; PG8_SCHED;
            } else {
            PG8_LDB(B0, 0, 0); PG8_SCHED; PG8_LDA(At, 0, 0); PG8_STAGE(PG8_SA(1, 1), a1 + hstep, voffA);
            PG8_WAIT_L(8); PG8_BAR; PG8_WAIT_L(0); PG8_MMA(0, 0, At, B0); PG8_BAR; PG8_SCHED;
            PG8_LDB(B1, 0, 1); PG8_STAGE(PG8_SB(0, 0), b2, voffB);
            PG8_BAR; PG8_WAIT_L(0); PG8_MMA(0, 1, At, B1); PG8_BAR;
            PG8_LDA(At, 0, 1); PG8_STAGE(PG8_SA(0, 0), a2, voffA);
            PG8_BAR; PG8_WAIT_L(0); PG8_MMA(1, 0, At, B0); PG8_BAR; PG8_SCHED;
            PG8_STAGE(PG8_SB(0, 1), b2 + hstep, voffB);
            PG8_WAIT_V(6); PG8_BAR; PG8_MMA(1, 1, At, B1); PG8_BAR;
            PG8_LDB(B0, 1, 0); PG8_SCHED; PG8_LDA(At, 1, 0); PG8_STAGE(PG8_SA(0, 1), a2 + hstep, voffA);
            PG8_WAIT_L(8); PG8_BAR; PG8_WAIT_L(0); PG8_MMA(0, 0, At, B0); PG8_BAR; PG8_SCHED;
            PG8_LDB(B1, 1, 1); PG8_STAGE(PG8_SB(1, 0), b3, voffB);
            PG8_BAR; PG8_WAIT_L(0); PG8_MMA(0, 1, At, B1); PG8_BAR;
            PG8_LDA(At, 1, 1); PG8_STAGE(PG8_SA(1, 0), a3, voffA);
            PG8_BAR; PG8_WAIT_L(0); PG8_MMA(1, 0, At, B0); PG8_BAR; PG8_SCHED;
            PG8_STAGE(PG8_SB(1, 1), b3 + hstep, voffB);
            PG8_WAIT_V(6); PG8_BAR; PG8_MMA(1, 1, At, B1); PG8_BAR;
            }
        }
        if constexpr (ALIGN_EPI) { if (wr == 0) PG8_BAR; }
        if constexpr (!Epi::AFTER_DRAIN) { E(acc, cur, wr, wc, fr, fq); S.done(cur); }
        if (!has_next) break;
#pragma unroll
        for (int a = 0; a < 2; ++a)
#pragma unroll
            for (int b = 0; b < 2; ++b)
#pragma unroll
                for (int m = 0; m < 4; ++m)
#pragma unroll
                    for (int n = 0; n < 2; ++n) acc[a][b][m][n] = (f32x4){0.f, 0.f, 0.f, 0.f};
        cur = nxt; cA = nA; cB = nB; ++ui;
        if constexpr (ALIGN_EPI) { if (wr == 1) PG8_BAR; }
    }
    PG8_WAIT_V(0);
    if constexpr (!ALIGN_EPI) { if (wr == 0) PG8_BAR; }
    PG8_BAR;
    if constexpr (Epi::AFTER_DRAIN) { E.fused(acc, cur, wr, wc, fr, fq, lds, wid, lane); S.done(cur); }
#undef PG8_SA
#undef PG8_SB
#undef PG8_STAGE
#undef PG8_LDA
#undef PG8_LDB
#undef PG8_MMA
#undef PG8_WAIT_V
#undef PG8_WAIT_L
#undef PG8_BAR
#undef PG8_SCHED
}
}

using pg8::bf16_t; using pg8::bf16x8; using pg8::f32x4; using pg8::u32x4; using pg8::u32x2; using pg8::pk2; using pg8::f2bf; using pg8::bf2f;
#define LAS __attribute__((address_space(3)))
typedef short s16x4 __attribute__((ext_vector_type(4)));
typedef float f32x16 __attribute__((ext_vector_type(16)));
#define MFMA32(a, b, c) __builtin_amdgcn_mfma_f32_32x32x16_bf16((a), (b), (c), 0, 0, 0)
#define MFMA16(a, b, c) __builtin_amdgcn_mfma_f32_16x16x32_bf16((a), (b), (c), 0, 0, 0)
#define LDS_FENCE() asm volatile("s_waitcnt lgkmcnt(0)" ::: "memory")
#define DI __device__ __forceinline__
constexpr int NWAVES = 8, NTHREADS = 512;
constexpr int LDS_BYTES = 147456;
constexpr int WSCR = 8448;
constexpr int YG_OFF = NWAVES * WSCR;
constexpr int YG_LD = 520;

DI int crow(int reg, int h) { return (reg & 3) + 8 * (reg >> 2) + 4 * h; }
DI float sigmoidf_(float x) { return 1.0f / (1.0f + __expf(-x)); }
DI float siluf_(float x) { return x * sigmoidf_(x); }
DI float gelu_tanh(float y) { const float t = 0.7978845608028654f * (y + 0.044715f * y * y * y); const float th = 1.0f - 2.0f / (__expf(2.0f * t) + 1.0f); return 0.5f * y * (1.0f + th); }
DI float wave_sum(float v) {
#pragma unroll
    for (int o = 1; o < 64; o <<= 1) v += __shfl_xor(v, o);
    return v;
}
DI float wave_max(float v) {
#pragma unroll
    for (int o = 1; o < 64; o <<= 1) v = fmaxf(v, __shfl_xor(v, o));
    return v;
}
DI void sincos_d(double ang, float& s, float& c) {
    const double TWO_PI = 6.283185307179586476925, INV_TWO_PI = 0.15915494309189533576888;
    const double k = rint(ang * INV_TWO_PI);
    const double r = ang - k * TWO_PI, r2 = r * r;
    double ss = 1.0, cc = 1.0;
#pragma unroll
    for (int n = 15; n >= 1; --n) { ss = 1.0 - ss * r2 * (1.0 / ((2.0 * n) * (2.0 * n + 1.0))); cc = 1.0 - cc * r2 * (1.0 / ((2.0 * n - 1.0) * (2.0 * n))); }
    s = (float)(r * ss); c = (float)cc;
}

constexpr int PTR_OFF = 140 * 1024, XB_LDS_OFF = 140 * 1024 + 512;
constexpr size_t WS_XBAR = 512 * 1024;
struct Ctx { unsigned char* ws; float* out; LAS unsigned char* lds; int lane, wave, gw, ngw; };
#define GAS __attribute__((address_space(1)))
DI const GAS float* INP(const Ctx& X, int i) { const volatile LAS unsigned* p = (const volatile LAS unsigned*)(X.lds + PTR_OFF + 8 * i);
    const unsigned lo = __builtin_amdgcn_readfirstlane(p[0]), hi = __builtin_amdgcn_readfirstlane(p[1]); return (const GAS float*)(((unsigned long long)hi << 32) | lo); }
#define W_ROWSS(X) ((unsigned long long*)((X).ws + WS_ROWSS))
#define W_AB(X)    ((float2*)((X).ws + WS_AB))
#define W_AT(X)    ((float2*)((X).ws + WS_AT))
#define W_BB(X)    ((bf16_t*)((X).ws + WS_BB))
#define W_CC(X)    ((bf16_t*)((X).ws + WS_CC))
#define W_ROPE(X)  ((float2*)((X).ws + WS_ROPE))
#define W_WSB(X)   ((bf16_t*)((X).ws + WS_WSB))
#define W_WGT(X)   ((bf16_t*)((X).ws + WS_WGT))
#define W_WOT(X)   ((bf16_t*)((X).ws + WS_WOT))
#define W_WIT(X)   ((bf16_t*)((X).ws + WS_WIT))
#define W_XB(X)    ((bf16_t*)((X).ws + WS_XB))
#define W_XRES(X)  ((float*)((X).ws + WS_XRES))
#define W_Z(X)     ((bf16_t*)((X).ws + WS_Z))
#define W_MIX(X)   ((bf16_t*)((X).ws + WS_MIX))
#define W_VT(X)    ((bf16_t*)((X).ws + WS_VT))
#define W_VAT(X)   ((bf16_t*)((X).ws + WS_VAT))
#define W_E(X)     ((float2*)((X).ws + WS_E))
#define W_H0(X)    ((float2*)((X).ws + WS_H0))
enum { I_XP = 0, I_XS, I_CK, I_CV, I_SRE, I_SIM, I_NG, I_FG, I_WIN, I_WOUT, I_CW, I_CB, I_SINK, I_ARE, I_AIM, I_LDT, I_BRE, I_BIM, I_CRE, I_CIM, I_DSK, I_GW, I_GB };

DI void p0_transpose_item(const GAS float* W, const GAS float* gk, int K, int N, bf16_t* WT, LAS float* scr, int item, int lane) {
    const int nblk = N / 32, kb = item / nblk, nb = item % nblk, k0 = 64 * kb, n0 = 32 * nb;
    const int r8 = lane >> 3, c4 = (lane & 7) * 4;
#pragma unroll
    for (int i = 0; i < 8; ++i) { const int kk = 8 * i + r8; f32x4 v = *(const GAS f32x4*)(W + (size_t)(k0 + kk) * N + n0 + c4); if (gk) v = v * gk[k0 + kk];
        LAS float* d = scr + kk * 33 + c4; d[0] = v[0]; d[1] = v[1]; d[2] = v[2]; d[3] = v[3]; }
    LDS_FENCE();
    const int c = lane & 7;
#pragma unroll
    for (int j = 0; j < 4; ++j) { const int n = (lane >> 3) + 8 * j; const LAS float* s = scr + (8 * c) * 33 + n;
        u32x4 o; o.x = pk2(s[0 * 33], s[1 * 33]); o.y = pk2(s[2 * 33], s[3 * 33]); o.z = pk2(s[4 * 33], s[5 * 33]); o.w = pk2(s[6 * 33], s[7 * 33]);
        *(u32x4*)(WT + (size_t)(n0 + n) * K + k0 + 8 * c) = o; }
    LDS_FENCE();
}

DI void convert_layer_weights(const Ctx& X, int l, int w_id, int n_w) {
    LAS float* scr = (LAS float*)(X.lds + X.wave * WSCR);
    constexpr int I_IN = (DM / 64) * (DIN / 32), I_OUT = (DM / 64) * (DM / 32), I_G = (512 / 64) * (512 / 32), I_L = I_IN + I_OUT + I_G;
    const GAS float* w_in = INP(X, I_WIN); const GAS float* w_out = INP(X, I_WOUT); const GAS float* glu_w = INP(X, I_GW); const GAS float* norm_g = INP(X, I_NG);
    for (int it = w_id; it < I_L; it += n_w) {
        int r = it;
        if (r < I_IN) { p0_transpose_item(w_in + (size_t)l * DM * DIN, norm_g + l * DM, DM, DIN, W_WIT(X) + (size_t)l * DIN * DM, scr, r, X.lane); continue; } r -= I_IN;
        if (r < I_OUT) { p0_transpose_item(w_out + (size_t)l * DM * DM, nullptr, DM, DM, W_WOT(X) + (size_t)l * DM * DM, scr, r, X.lane); continue; } r -= I_OUT;
        p0_transpose_item(glu_w + (size_t)l * 512 * 512, nullptr, 512, 512, W_WGT(X) + (size_t)l * 512 * 512, scr, r, X.lane);
    }
}

DI void phase_prologue(const Ctx& X) {
    convert_layer_weights(X, 0, X.gw, X.ngw);
    if (gridDim.x < 16) { for (int l = 1; l < NLAYER; ++l) convert_layer_weights(X, l, X.gw, X.ngw); }
    { const GAS float* x_prompt = INP(X, I_XP); const GAS float* x_sample = INP(X, I_XS);
    for (int m = X.gw; m < MROWS; m += X.ngw) {
        const GAS float* xr = (m < 8192) ? (x_prompt + (size_t)m * DM) : (x_sample + (size_t)(m - 8192) * DM);
        float ss = 0.f;
#pragma unroll
        for (int j = 0; j < 8; ++j) { const f32x4 v = *(const GAS f32x4*)(xr + 4 * X.lane + 256 * j); ss += (v[0] * v[0] + v[1] * v[1]) + (v[2] * v[2] + v[3] * v[3]);
            u32x2 w; w.x = pk2(v[0], v[1]); w.y = pk2(v[2], v[3]); *(u32x2*)(W_XB(X) + (size_t)m * DM + 4 * X.lane + 256 * j) = w; }
        ss = wave_sum(ss);
        if (X.lane == 0) W_ROWSS(X)[m] = (unsigned long long)(ss * 4294967296.0f);
    } }
    const int gt = X.gw * 64 + X.lane, ngt = X.ngw * 64;
    { const GAS float* log_dt = INP(X, I_LDT); const GAS float* a_re = INP(X, I_ARE); const GAS float* a_im = INP(X, I_AIM); const GAS float* b_re = INP(X, I_BRE); const GAS float* b_im = INP(X, I_BIM);
      const GAS float* c_re = INP(X, I_CRE); const GAS float* c_im = INP(X, I_CIM);
    for (int i = gt; i < NLAYER * 32 * 64; i += ngt) {
        const int lg = i >> 6, p = i & 63;
        const float dt = expf(log_dt[lg]); const float ar = a_re[i], ai = a_im[i];
        float sn, cs; sincos_d((double)ai * (double)dt, sn, cs);
        const float mag = expf(ar * dt); const float abr = mag * cs, abi = mag * sn;
        W_AB(X)[i] = make_float2(abr, abi);
        float sn32, cs32; sincos_d((double)ai * (double)dt * 32.0, sn32, cs32);
        const float mag32 = expf(ar * dt * 32.0f);
        W_AT(X)[i] = make_float2(mag32 * cs32, mag32 * sn32);
        const float nr = abr - 1.0f, ni = abi, den = ar * ar + ai * ai;
        const float f_re = (nr * ar + ni * ai) / den, f_im = (ni * ar - nr * ai) / den;
        unsigned wr[8], wi[8];
#pragma unroll
        for (int c2 = 0; c2 < 8; ++c2) {
            const float br0 = b_re[(size_t)i * 16 + 2 * c2], bi0 = b_im[(size_t)i * 16 + 2 * c2], br1 = b_re[(size_t)i * 16 + 2 * c2 + 1], bi1 = b_im[(size_t)i * 16 + 2 * c2 + 1];
            wr[c2] = pk2(f_re * br0 - f_im * bi0, f_re * br1 - f_im * bi1);
            wi[c2] = pk2(f_re * bi0 + f_im * br0, f_re * bi1 + f_im * br1);
        }
        u32x4* rowr = (u32x4*)(W_BB(X) + ((size_t)lg * 128 + p) * 16); u32x4* rowi = (u32x4*)(W_BB(X) + ((size_t)lg * 128 + 64 + p) * 16);
        rowr[0] = (u32x4){wr[0], wr[1], wr[2], wr[3]}; rowr[1] = (u32x4){wr[4], wr[5], wr[6], wr[7]};
        rowi[0] = (u32x4){wi[0], wi[1], wi[2], wi[3]}; rowi[1] = (u32x4){wi[4], wi[5], wi[6], wi[7]};
    }
    for (int j = gt; j < NLAYER * 32 * 16 * 16; j += ngt) {
        const int kc = j & 15, lc = j >> 4, k0 = 8 * kc;
        const GAS float* src = (k0 < 64) ? (c_re + (size_t)lc * 64 + k0) : (c_im + (size_t)lc * 64 + (k0 - 64));
        const float sg = (k0 < 64) ? 1.0f : -1.0f;
        const f32x4 a0 = *(const GAS f32x4*)src, a1 = *(const GAS f32x4*)(src + 4);
        u32x4 w; w.x = pk2(sg * a0[0], sg * a0[1]); w.y = pk2(sg * a0[2], sg * a0[3]); w.z = pk2(sg * a1[0], sg * a1[1]); w.w = pk2(sg * a1[2], sg * a1[3]);
        *(u32x4*)(W_CC(X) + (size_t)lc * 128 + k0) = w;
    } }
    { const GAS float* chunk_w = INP(X, I_CW);
    for (int j = gt; j < NLAYER * 4 * 128 * 16; j += ngt) {
        const int t = (j >> 4) & 127, s0 = (j & 15) * 8;
        const f32x4 a0 = *(const GAS f32x4*)(chunk_w + (size_t)j * 8), a1 = *(const GAS f32x4*)(chunk_w + (size_t)j * 8 + 4);
        float v[8] = {a0[0], a0[1], a0[2], a0[3], a1[0], a1[1], a1[2], a1[3]};
#pragma unroll
        for (int e = 0; e < 8; ++e) v[e] = (s0 + e <= t) ? v[e] : 0.0f;
        u32x4 w; w.x = pk2(v[0], v[1]); w.y = pk2(v[2], v[3]); w.z = pk2(v[4], v[5]); w.w = pk2(v[6], v[7]);
        *(u32x4*)(W_WSB(X) + (size_t)j * 8) = w;
    } }
    for (int i = gt; i < 4104 * 8; i += ngt) {
        const int pi = i >> 3, j = i & 7;
        const double inv[8] = {1.0, 0.19392274474868576, 0.03760603093086393, 0.007292664737217109, 0.001414213562373095, 0.0002742481756762073, 5.318295896944988e-05, 1.031338537721246e-05};
        double iv = inv[0];
#pragma unroll
        for (int q = 1; q < 8; ++q) iv = (j == q) ? inv[q] : iv;
        const double pos = (pi < 4096) ? (double)pi : (double)(16384 + (pi - 4096));
        float sn, cs; sincos_d(pos * iv, sn, cs);
        W_ROPE(X)[i] = make_float2(cs, sn);
    }
}

DI float2 ld_e(const float2* p) { const unsigned long long v = __hip_atomic_load((const unsigned long long*)p, __ATOMIC_RELAXED, __HIP_MEMORY_SCOPE_SYSTEM); float2 r; r.x = __uint_as_float((unsigned)v); r.y = __uint_as_float((unsigned)(v >> 32)); return r; }
template <bool PASS_C>
DI void s5_wave_unit(const Ctx& X, int layer, int u, int slot, LAS float* bu, LAS bf16_t* yg) {
    const int lane = X.lane, r31 = lane & 31, h = lane >> 5;
    const int R0 = 32 * u; const bool samp = (u >= 256);
    const int b = u >> 7, chn = u & 127;
    const GAS float* st_re = INP(X, I_SRE); const GAS float* st_im = INP(X, I_SIM); const GAS float* dskip = INP(X, I_DSK);
    for (int gi = 0; gi < 4; ++gi) {
        const int g = 4 * slot + gi, lg = layer * 32 + g;
        const float2 ab = W_AB(X)[lg * 64 + lane];
        float hr = 0.f, hi = 0.f;
        if (PASS_C && !samp) { const float2 h0 = W_H0(X)[((size_t)(b * 128 + chn) * 32 + g) * 64 + lane]; hr = h0.x; hi = h0.y; }
        bf16x8 ua = *(const bf16x8*)(W_Z(X) + (size_t)(R0 + r31) * DIN + C_UC + 16 * g + 8 * h);
        bf16x8 bbf[4];
#pragma unroll
        for (int nt = 0; nt < 4; ++nt) bbf[nt] = *(const bf16x8*)(W_BB(X) + ((size_t)lg * 128 + 32 * nt + r31) * 16 + 8 * h);
        f32x16 acc[4];
#pragma unroll
        for (int nt = 0; nt < 4; ++nt) {
            f32x16 zz;
#pragma unroll
            for (int i = 0; i < 16; ++i) zz[i] = 0.f;
            asm volatile("" : "+v"(zz));
            acc[nt] = MFMA32(ua, bbf[nt], zz);
        }
        __builtin_amdgcn_sched_barrier(0);
        asm volatile("s_nop 15\n\ts_nop 15\n\ts_nop 15\n\ts_nop 15\n\ts_nop 15\n\ts_nop 15\n\ts_nop 15\n\ts_nop 15"
                     : "+v"(ua), "+v"(bbf[0]), "+v"(bbf[1]), "+v"(bbf[2]), "+v"(bbf[3]), "+v"(acc[0]), "+v"(acc[1]), "+v"(acc[2]), "+v"(acc[3]) :: "memory");
        __builtin_amdgcn_sched_barrier(0);
        bf16x8 cfrag[4];
        if (PASS_C) {
#pragma unroll
            for (int kk = 0; kk < 4; ++kk) cfrag[kk] = *(const bf16x8*)(W_CC(X) + ((size_t)lg * 16 + (lane & 15)) * 128 + 32 * kk + 8 * (lane >> 4));
        }
        const float dsk = PASS_C ? dskip[layer * 512 + 16 * g + (lane & 15)] : 0.f;
#pragma unroll
        for (int half = 0; half < 2; ++half) {
#pragma unroll
            for (int nt = 0; nt < 4; ++nt)
#pragma unroll
                for (int rr = 0; rr < 8; ++rr) bu[((rr & 3) + 8 * (rr >> 2) + 4 * h) * 132 + 32 * nt + r31] = acc[nt][8 * half + rr];
            LDS_FENCE();
            for (int tl = 0; tl < 16; ++tl) {
                const int t = 16 * half + tl;
                if (samp && (t & 7) == 0) { const size_t si = ((size_t)(layer * 32 + ((R0 - 8192 + t) >> 3)) * 32 + g) * 64 + lane; hr = st_re[si]; hi = st_im[si]; }
                const float br = bu[tl * 132 + lane], bi = bu[tl * 132 + 64 + lane];
                const float nr = ab.x * hr - ab.y * hi + br, ni = ab.x * hi + ab.y * hr + bi; hr = nr; hi = ni;
                if (PASS_C) {
                    LDS_FENCE();
                    LAS bf16_t* hs = (LAS bf16_t*)(bu + tl * 132); hs[lane] = f2bf(hr); hs[64 + lane] = f2bf(hi);
                    if (samp && (t & 7) == 7) { const size_t so = ((size_t)(layer * 32 + ((R0 - 8192 + t) >> 3)) * 32 + g) * 64 + lane; X.out[OFF_HRS + so] = hr; X.out[OFF_HIS + so] = hi; }
                }
            }
            LDS_FENCE();
            if (PASS_C) {
                f32x4 d = {0.f, 0.f, 0.f, 0.f}; asm volatile("" : "+v"(d));
#pragma unroll
                for (int kk = 0; kk < 4; ++kk) { const bf16x8 a = *(const LAS bf16x8*)((const LAS unsigned char*)bu + (lane & 15) * 528 + (32 * kk + 8 * (lane >> 4)) * 2); d = MFMA16(a, cfrag[kk], d); }
                __builtin_amdgcn_sched_barrier(0); asm volatile("s_nop 15\n\ts_nop 15\n\ts_nop 15" ::: "memory"); __builtin_amdgcn_sched_barrier(0);
                const int ch = 16 * g + (lane & 15);
#pragma unroll
                for (int reg = 0; reg < 4; ++reg) { const int t = 16 * half + 4 * (lane >> 4) + reg; const float uval = bf2f(W_Z(X)[(size_t)(R0 + t) * DIN + C_UC + ch]);
                    yg[t * YG_LD + ch] = f2bf(gelu_tanh(d[reg] + dsk * uval)); }
                LDS_FENCE();
            }
        }
        if (!PASS_C) { W_E(X)[((size_t)(b * 128 + chn) * 32 + g) * 64 + lane] = make_float2(hr, hi); }
        else if (!samp && chn == 127) { const size_t so = ((size_t)(layer * 2 + b) * 32 + g) * 64 + lane; X.out[OFF_HRP + so] = hr; X.out[OFF_HIP + so] = hi; }
    }
}

DI void phase_s5c(const Ctx& X, int layer, int u_first, int u_end) {
    LAS float* bu = (LAS float*)(X.lds + X.wave * WSCR);
    LAS bf16_t* yg = (LAS bf16_t*)(X.lds + YG_OFF);
    const int lane = X.lane, r31 = lane & 31, h = lane >> 5;
    const GAS float* glu_b = INP(X, I_GB);
    for (int u = u_first; u < u_end; u += gridDim.x) {
        s5_wave_unit<true>(X, layer, u, X.wave, bu, yg);
        LDS_FENCE(); __syncthreads();
        f32x16 ga[2];
#pragma unroll
        for (int nt = 0; nt < 2; ++nt)
#pragma unroll
            for (int i = 0; i < 16; ++i) ga[nt][i] = 0.f;
        asm volatile("" : "+v"(ga[0]), "+v"(ga[1]));
        const bf16_t* wg = W_WGT(X) + ((size_t)layer * 512 + 64 * X.wave + r31) * 512 + 8 * h;
#pragma unroll 1
        for (int kb = 0; kb < 4; ++kb) {
            bf16x8 af8[8], bf8[8][2];
#pragma unroll
            for (int k8 = 0; k8 < 8; ++k8) { const int ks = 8 * kb + k8; af8[k8] = *(const LAS bf16x8*)(yg + r31 * YG_LD + 16 * ks + 8 * h);
#pragma unroll
                for (int nt = 0; nt < 2; ++nt) bf8[k8][nt] = *(const bf16x8*)(wg + (size_t)nt * 32 * 512 + 16 * ks); }
#pragma unroll
            for (int k8 = 0; k8 < 8; ++k8)
#pragma unroll
                for (int nt = 0; nt < 2; ++nt) ga[nt] = MFMA32(af8[k8], bf8[k8][nt], ga[nt]);
            __builtin_amdgcn_sched_barrier(0); asm volatile("s_nop 15\n\ts_nop 15\n\ts_nop 15\n\ts_nop 15\n\ts_nop 15\n\ts_nop 15" ::: "memory"); __builtin_amdgcn_sched_barrier(0);
        }
        const int R0 = 32 * u;
#pragma unroll
        for (int nt = 0; nt < 2; ++nt) {
            const int n = 64 * X.wave + 32 * nt + r31; const float bg = glu_b[layer * 512 + n];
#pragma unroll
            for (int reg = 0; reg < 16; ++reg) { const int t = crow(reg, h); const size_t row = (size_t)(R0 + t);
                const float gate = sigmoidf_(ga[nt][reg] + bg); const float yv = bf2f(yg[t * YG_LD + n]); const float gc = bf2f(W_Z(X)[row * DIN + C_GC + n]);
                W_MIX(X)[row * DM + 1536 + n] = f2bf(yv * gate * siluf_(gc)); }
        }
        LDS_FENCE(); __syncthreads();
    }
}

DI void attn_item(const Ctx& X, int layer, int it) {
    const int lane = X.lane, r31 = lane & 31, h = lane >> 5;
    const int qt = it & 3, rr = (it >> 2) & 3, g = (it >> 4) & 3, blk = (it >> 6) & 31, b = it >> 11;
    const int head = 4 * g + rr, q0 = blk * 128 + 32 * qt, kbase = q0 - 128;
    const size_t rowb = (size_t)b * 4096;
    bf16x8 qf[4];
#pragma unroll
    for (int ks = 0; ks < 4; ++ks) qf[ks] = *(const bf16x8*)(W_Z(X) + (rowb + q0 + r31) * DIN + C_Q + 64 * head + 16 * ks + 8 * h);
    f32x16 S[5];
#pragma unroll
    for (int kb = 0; kb < 2; ++kb) {
        bf16x8 kf[3][4];
#pragma unroll
        for (int kk = 0; kk < 3; ++kk) { const int kt = 3 * kb + kk; if (kt < 5) {
            int tk = kbase + 32 * kt + r31; tk = tk < 0 ? 0 : tk;
            const bf16_t* kp = W_Z(X) + (rowb + tk) * DIN + C_K + 64 * g + 8 * h;
#pragma unroll
            for (int ks = 0; ks < 4; ++ks) kf[kk][ks] = *(const bf16x8*)(kp + 16 * ks); } }
#pragma unroll
        for (int kk = 0; kk < 3; ++kk) { const int kt = 3 * kb + kk; if (kt < 5) {
            f32x16 s;
#pragma unroll
            for (int i = 0; i < 16; ++i) s[i] = 0.f;
            asm volatile("" : "+v"(s));
#pragma unroll
            for (int ks = 0; ks < 4; ++ks) s = MFMA32(kf[kk][ks], qf[ks], s);
            S[kt] = s; } }
        __builtin_amdgcn_sched_barrier(0);
        asm volatile("s_nop 15\n\ts_nop 15\n\ts_nop 15\n\ts_nop 15\n\ts_nop 15\n\ts_nop 15\n\ts_nop 15\n\ts_nop 15" ::: "memory");
        __builtin_amdgcn_sched_barrier(0);
    }
    const float sink = INP(X, I_SINK)[layer * 16 + head];
    float m = sink;
#pragma unroll
    for (int kt = 0; kt < 5; ++kt)
#pragma unroll
        for (int reg = 0; reg < 16; ++reg) { const int jj = 32 * kt + crow(reg, h), dl = jj - r31; const bool ok = (dl >= 1) && (dl <= 128) && (kbase + jj >= 0);
            const float s = ok ? S[kt][reg] * 0.125f : -1e30f; S[kt][reg] = s; m = fmaxf(m, s); }
    m = fmaxf(m, __shfl_xor(m, 32));
    float sum = 0.f;
#pragma unroll
    for (int kt = 0; kt < 5; ++kt)
#pragma unroll
        for (int reg = 0; reg < 16; ++reg) { const float p = __expf(S[kt][reg] - m); S[kt][reg] = p; sum += p; }
    sum += __shfl_xor(sum, 32); sum += __expf(sink - m);
    const float inv = 1.0f / sum;
    f32x16 O[2];
#pragma unroll
    for (int dt = 0; dt < 2; ++dt)
#pragma unroll
        for (int i = 0; i < 16; ++i) O[dt][i] = 0.f;
    asm volatile("" : "+v"(O[0]), "+v"(O[1]));
#pragma unroll
    for (int kt = 0; kt < 5; ++kt)
#pragma unroll
        for (int s2 = 0; s2 < 2; ++s2) {
            u32x4 pw; pw.x = pk2(S[kt][8 * s2 + 0], S[kt][8 * s2 + 1]); pw.y = pk2(S[kt][8 * s2 + 2], S[kt][8 * s2 + 3]); pw.z = pk2(S[kt][8 * s2 + 4], S[kt][8 * s2 + 5]); pw.w = pk2(S[kt][8 * s2 + 6], S[kt][8 * s2 + 7]);
            const bf16x8 pf = __builtin_bit_cast(bf16x8, pw);
            const int tk = kbase + 32 * kt + 16 * s2 + 4 * h; const int t0 = tk < 0 ? 0 : tk, t1 = (tk + 8) < 0 ? 0 : (tk + 8);
            s16x4 vlo[2], vhi[2];
#pragma unroll
            for (int dt = 0; dt < 2; ++dt) { const bf16_t* vp = W_VT(X) + ((size_t)((b * 4 + g) * 64 + 32 * dt + r31)) * 4096; vlo[dt] = *(const s16x4*)(vp + t0); vhi[dt] = *(const s16x4*)(vp + t1); }
#pragma unroll
            for (int dt = 0; dt < 2; ++dt) {
                const bf16x8 vf = __builtin_shufflevector(vlo[dt], vhi[dt], 0, 1, 2, 3, 4, 5, 6, 7);
                O[dt] = MFMA32(vf, pf, O[dt]);
            }
            __builtin_amdgcn_sched_barrier(0); asm volatile("s_nop 15\n\ts_nop 15\n\ts_nop 15\n\ts_nop 15" ::: "memory"); __builtin_amdgcn_sched_barrier(0);
        }
    const size_t rq = rowb + q0 + r31;
#pragma unroll
    for (int dt = 0; dt < 2; ++dt)
#pragma unroll
        for (int rg = 0; rg < 4; ++rg) {
            const int d0 = 32 * dt + 8 * rg + 4 * h;
            const u32x2 gw2 = *(const u32x2*)(W_Z(X) + rq * DIN + C_GB + 64 * head + d0);
            const float g0 = __uint_as_float(gw2.x << 16), g1 = __uint_as_float(gw2.x & 0xffff0000u), g2 = __uint_as_float(gw2.y << 16), g3 = __uint_as_float(gw2.y & 0xffff0000u);
            u32x2 w; w.x = pk2(O[dt][4 * rg + 0] * inv * siluf_(g0), O[dt][4 * rg + 1] * inv * siluf_(g1)); w.y = pk2(O[dt][4 * rg + 2] * inv * siluf_(g2), O[dt][4 * rg + 3] * inv * siluf_(g3));
            *(u32x2*)(W_MIX(X) + rq * DM + 512 + 64 * head + d0) = w;
        }
}

DI void chunk_item(const Ctx& X, int layer, int it) {
    const int lane = X.lane, r31 = lane & 31, h = lane >> 5;
    const int sub = it & 7, hh = (it >> 3) & 3, chunk = it >> 5, ct = sub & 3, th = sub >> 2;
    const GAS float* chunk_b = INP(X, I_CB);
    const bf16_t* ap = W_VAT(X) + ((size_t)(128 * hh + 32 * ct + r31)) * 8192 + chunk * 128 + 8 * h;
    bf16x8 af[8];
#pragma unroll
    for (int ks = 0; ks < 8; ++ks) af[ks] = *(const bf16x8*)(ap + 16 * ks);
#pragma unroll
    for (int t2 = 0; t2 < 2; ++t2) {
        const int tt = 2 * th + t2, t = 32 * tt + r31;
        const bf16_t* bp = W_WSB(X) + ((size_t)((layer * 4 + hh) * 128 + t)) * 128 + 8 * h;
        bf16x8 bfr[8];
        f32x16 d;
#pragma unroll
        for (int i = 0; i < 16; ++i) d[i] = 0.f;
        asm volatile("" : "+v"(d));
#pragma unroll
        for (int ks = 0; ks < 8; ++ks) bfr[ks] = *(const bf16x8*)(bp + 16 * ks);
#pragma unroll
        for (int ks = 0; ks < 8; ++ks) if (ks < 2 * (tt + 1)) d = MFMA32(af[ks], bfr[ks], d);
        __builtin_amdgcn_sched_barrier(0); asm volatile("s_nop 15\n\ts_nop 15\n\ts_nop 15\n\ts_nop 15\n\ts_nop 15\n\ts_nop 15" ::: "memory"); __builtin_amdgcn_sched_barrier(0);
        const size_t row = (size_t)chunk * 128 + t; const float bs = chunk_b[(layer * 4 + hh) * 128 + t];
#pragma unroll
        for (int rg = 0; rg < 4; ++rg) {
            const int c0 = 128 * hh + 32 * ct + 8 * rg + 4 * h;
            const u32x2 uw = *(const u32x2*)(W_Z(X) + row * DIN + C_UA + c0), gw2 = *(const u32x2*)(W_Z(X) + row * DIN + C_GA + c0);
            const float u0 = __uint_as_float(uw.x << 16), u1 = __uint_as_float(uw.x & 0xffff0000u), u2 = __uint_as_float(uw.y << 16), u3 = __uint_as_float(uw.y & 0xffff0000u);
            const float g0 = __uint_as_float(gw2.x << 16), g1 = __uint_as_float(gw2.x & 0xffff0000u), g2 = __uint_as_float(gw2.y << 16), g3 = __uint_as_float(gw2.y & 0xffff0000u);
            u32x2 w; w.x = pk2(u0 * (d[4 * rg + 0] + bs) * siluf_(g0), u1 * (d[4 * rg + 1] + bs) * siluf_(g1)); w.y = pk2(u2 * (d[4 * rg + 2] + bs) * siluf_(g2), u3 * (d[4 * rg + 3] + bs) * siluf_(g3));
            *(u32x2*)(W_MIX(X) + row * DM + c0) = w;
        }
    }
}

DI void sample_chunk_item(const Ctx& X, int layer, int it) {
    const int lane = X.lane, seq = it >> 2, hh = it & 3;
    const size_t row0 = 8192 + (size_t)seq * 8;
    const GAS float* chunk_b = INP(X, I_CB); const GAS float* chunk_w = INP(X, I_CW);
#pragma unroll
    for (int cpass = 0; cpass < 2; ++cpass) {
        const int ch = 128 * hh + 64 * cpass + lane;
        float va[8];
#pragma unroll
        for (int s = 0; s < 8; ++s) va[s] = bf2f(W_Z(X)[(row0 + s) * DIN + C_VA + ch]);
#pragma unroll
        for (int t = 0; t < 8; ++t) {
            float a = chunk_b[(layer * 4 + hh) * 128 + t];
#pragma unroll
            for (int s = 0; s < 8; ++s) if (s <= t) a += chunk_w[((size_t)((layer * 4 + hh) * 128 + t)) * 128 + s] * va[s];
            const float uu = bf2f(W_Z(X)[(row0 + t) * DIN + C_UA + ch]), gg = bf2f(W_Z(X)[(row0 + t) * DIN + C_GA + ch]);
            W_MIX(X)[(row0 + t) * DM + ch] = f2bf(uu * a * siluf_(gg));
        }
    }
}

DI void sample_attn_item(const Ctx& X, int layer, int it, LAS float* scr) {
    const int lane = X.lane, seq = it >> 4, head = it & 15, g = head >> 2;
    const size_t row0 = 8192 + (size_t)seq * 8;
    LAS float* Q = scr; LAS float* P = scr + 512;
    const bf16_t* z = W_Z(X);
#pragma unroll
    for (int i = 0; i < 8; ++i) Q[i * 64 + lane] = bf2f(z[(row0 + i) * DIN + C_Q + 64 * head + lane]) * 0.125f;
    LDS_FENCE();
    const float sink = INP(X, I_SINK)[layer * 16 + head];
    const GAS float* cache_k = INP(X, I_CK);
#pragma unroll 1
    for (int rd = 0; rd < 3; ++rd) {
        const int j = 64 * rd + lane;
        float kv[64];
        if (rd < 2) {
            const GAS float* kp = cache_k + (((size_t)(layer * 32 + seq) * 128 + j) * 4 + g) * 64;
#pragma unroll
            for (int d4 = 0; d4 < 16; ++d4) { const f32x4 v = *(const GAS f32x4*)(kp + 4 * d4); kv[4 * d4] = v[0]; kv[4 * d4 + 1] = v[1]; kv[4 * d4 + 2] = v[2]; kv[4 * d4 + 3] = v[3]; }
        } else {
            const int jn = (lane < 8) ? lane : 0;
            const bf16_t* kp = z + (row0 + jn) * DIN + C_K + 64 * g;
#pragma unroll
            for (int d8 = 0; d8 < 8; ++d8) { const u32x4 w = *(const u32x4*)(kp + 8 * d8);
#pragma unroll
                for (int e = 0; e < 4; ++e) { kv[8 * d8 + 2 * e] = __uint_as_float(w[e] << 16); kv[8 * d8 + 2 * e + 1] = __uint_as_float(w[e] & 0xffff0000u); } }
        }
#pragma unroll
        for (int i = 0; i < 8; ++i) {
            float a = 0.f;
#pragma unroll
            for (int d4 = 0; d4 < 16; ++d4) { const f32x4 q = *(const LAS f32x4*)(Q + i * 64 + 4 * d4); a += q[0] * kv[4 * d4] + q[1] * kv[4 * d4 + 1] + q[2] * kv[4 * d4 + 2] + q[3] * kv[4 * d4 + 3]; }
            const int dl = j - i; const bool ok = (j < 136) && (dl >= 1) && (dl <= 128);
            if (j < 136) P[j * 8 + i] = ok ? a : -1e30f;
        }
    }
    LDS_FENCE();
    float inv[8];
#pragma unroll
    for (int i = 0; i < 8; ++i) {
        const float s0 = P[lane * 8 + i], s1 = P[(64 + lane) * 8 + i], s2 = (lane < 8) ? P[(128 + lane) * 8 + i] : -1e30f;
        const float m = fmaxf(wave_max(fmaxf(fmaxf(s0, s1), s2)), sink);
        const float p0 = __expf(s0 - m), p1 = __expf(s1 - m), p2 = (lane < 8) ? __expf(s2 - m) : 0.f;
        inv[i] = 1.0f / (wave_sum(p0 + p1 + p2) + __expf(sink - m));
        P[lane * 8 + i] = p0; P[(64 + lane) * 8 + i] = p1; if (lane < 8) P[(128 + lane) * 8 + i] = p2;
    }
    LDS_FENCE();
    float o[8];
#pragma unroll
    for (int i = 0; i < 8; ++i) o[i] = 0.f;
    const GAS float* vp = INP(X, I_CV) + (((size_t)(layer * 32 + seq) * 128) * 4 + g) * 64 + lane;
#pragma unroll 16
    for (int j = 0; j < 128; ++j) { const float v = vp[(size_t)j * 256]; const f32x4 p0 = *(const LAS f32x4*)(P + j * 8), p1 = *(const LAS f32x4*)(P + j * 8 + 4);
        o[0] += p0[0] * v; o[1] += p0[1] * v; o[2] += p0[2] * v; o[3] += p0[3] * v; o[4] += p1[0] * v; o[5] += p1[1] * v; o[6] += p1[2] * v; o[7] += p1[3] * v; }
#pragma unroll
    for (int jn = 0; jn < 8; ++jn) { const float v = bf2f(z[(row0 + jn) * DIN + C_V + 64 * g + lane]); const f32x4 p0 = *(const LAS f32x4*)(P + (128 + jn) * 8), p1 = *(const LAS f32x4*)(P + (128 + jn) * 8 + 4);
        o[0] += p0[0] * v; o[1] += p0[1] * v; o[2] += p0[2] * v; o[3] += p0[3] * v; o[4] += p1[0] * v; o[5] += p1[1] * v; o[6] += p1[2] * v; o[7] += p1[3] * v; }
#pragma unroll
    for (int i = 0; i < 8; ++i) { const float gb = bf2f(z[(row0 + i) * DIN + C_GB + 64 * head + lane]); W_MIX(X)[(row0 + i) * DM + 512 + 64 * head + lane] = f2bf(o[i] * inv[i] * siluf_(gb)); }
    LDS_FENCE();
}

DI void phase_mixA(const Ctx& X, int layer) {
    LAS float* scr = (LAS float*)(X.lds + X.wave * WSCR);
    constexpr int N_ATT = 4096, N_CH = 2048, N_SA = 512, N_SC = 128, N_S5 = 2048;
    for (int it = X.gw; it < N_S5; it += X.ngw) s5_wave_unit<false>(X, layer, it >> 3, it & 7, scr, nullptr);
    for (int it = X.gw; it < N_SA; it += X.ngw) sample_attn_item(X, layer, it, scr);
    for (int it = X.gw; it < N_SC; it += X.ngw) sample_chunk_item(X, layer, it);
    if (gridDim.x >= 72 && blockIdx.x >= 64 && blockIdx.x < 72) { asm volatile("s_waitcnt vmcnt(0) lgkmcnt(0)" ::: "memory"); __syncthreads(); phase_s5c(X, layer, 256 + (int)blockIdx.x - 64, 264); }
    else if (gridDim.x < 72) { asm volatile("s_waitcnt vmcnt(0) lgkmcnt(0)" ::: "memory"); __syncthreads(); phase_s5c(X, layer, 256 + (int)blockIdx.x, 264); }
    if (gridDim.x == 256 && blockIdx.x >= 72) {
        for (int it = X.gw - 72 * NWAVES; it < 2048; it += (256 - 72) * NWAVES) chunk_item(X, layer, it);
        if (layer + 1 < NLAYER) { asm volatile("s_waitcnt vmcnt(0) lgkmcnt(0)" ::: "memory"); convert_layer_weights(X, layer + 1, X.gw - 72 * NWAVES, (256 - 72) * NWAVES); }
    }
}

DI void phase_carry(const Ctx& X, int layer) {
    const int lane = X.lane;
    for (int it = X.gw; it < 64; it += X.ngw) {
        const int b = it >> 5, g = it & 31, lg = layer * 32 + g;
        const float2 aT = W_AT(X)[lg * 64 + lane];
        const float2* Ep = W_E(X) + ((size_t)(b * 128) * 32 + g) * 64 + lane;
        float2* Hp = W_H0(X) + ((size_t)(b * 128) * 32 + g) * 64 + lane;
        float hr = 0.f, hi = 0.f;
        for (int c = 0; c < 128; c += 16) {
            float2 e[16];
#pragma unroll
            for (int j = 0; j < 16; ++j) e[j] = Ep[(size_t)(c + j) * 2048];
#pragma unroll
            for (int j = 0; j < 16; ++j) { Hp[(size_t)(c + j) * 2048] = make_float2(hr, hi); const float nr = aT.x * hr - aT.y * hi + e[j].x, ni = aT.x * hi + aT.y * hr + e[j].y; hr = nr; hi = ni; }
        }
    }
}

DI void phase_final(const Ctx& X) {
    const GAS float* final_g = INP(X, I_FG);
    for (int m = X.gw; m < MROWS; m += X.ngw) {
        const float rs = rsqrtf((float)W_ROWSS(X)[4 * MROWS + m] * (2.3283064365386963e-10f / 2048.0f) + 1e-5f);
#pragma unroll
        for (int j = 0; j < 8; ++j) { const int c = 4 * X.lane + 256 * j; const f32x4 v = *(const f32x4*)(W_XRES(X) + (size_t)m * DM + c); const f32x4 gg = *(const GAS f32x4*)(final_g + c);
            *(f32x4*)(X.out + OFF_Y + (size_t)m * DM + c) = v * rs * gg; }
    }
}

#define XB_TMO      128
#define XB_XCNT(j)  (256  + 64 * (j))
#define XB_XSUB(j)  (1280 + 64 * (j))
#define XB_XGEN(j)  (2304 + 64 * (j))
#define XB_TOP      3328
#define XB_TOPGEN   3392
#define XCD_BAR_WORDS 3456
#define XB_SPIN_CAP (1u << 18)

__device__ __forceinline__ unsigned xb_ld(unsigned* p)              { return __hip_atomic_load(p, __ATOMIC_RELAXED, __HIP_MEMORY_SCOPE_AGENT); }
__device__ __forceinline__ unsigned xb_add(unsigned* p, unsigned v) { return __hip_atomic_fetch_add(p, v, __ATOMIC_RELAXED, __HIP_MEMORY_SCOPE_AGENT); }
__device__ __forceinline__ unsigned xb_xcc_id() { return (unsigned)__builtin_amdgcn_s_getreg((3 << 11) | 20) & 0xFu; }
#define XB_SPIN(cond, bar) do { unsigned _sp = 0; while (cond) { __builtin_amdgcn_s_sleep(1); \
    if ((++_sp & 255u) == 0u) { if (xb_ld(&(bar)[XB_TMO])) break; if (_sp > XB_SPIN_CAP) { atomicAdd(&(bar)[XB_TMO], 1u); break; } } } } while (0)

struct XcdBarrier {
    unsigned* bar; unsigned x;
    volatile LAS unsigned* st;
};

__device__ __forceinline__ XcdBarrier xcd_barrier_post(unsigned* bar, volatile LAS unsigned* st) {
    XcdBarrier b; b.bar = bar; b.x = xb_xcc_id(); b.st = st;
    if (threadIdx.x == 0) (void)xb_add(&bar[XB_XCNT(b.x)], 1u);
    return b;
}
__device__ __forceinline__ void xcd_barrier_complete(unsigned* bar, unsigned x, unsigned& nloc, unsigned& nx) {
    const unsigned G = gridDim.x * gridDim.y * gridDim.z;
    unsigned sum, cnt, mine, sp = 0u;
    for (;;) {
        sum = 0u; cnt = 0u; mine = 0u;
#pragma unroll
        for (unsigned j = 0; j < 16; ++j) { const unsigned c = xb_ld(&bar[XB_XCNT(j)]); sum += c; cnt += (c > 0u) ? 1u : 0u; mine = (j == x) ? c : mine; }
        if (sum == G) break;
        __builtin_amdgcn_s_sleep(1);
        if ((++sp & 255u) == 0u) { if (xb_ld(&bar[XB_TMO])) break; if (sp > XB_SPIN_CAP) { atomicAdd(&bar[XB_TMO], 1u); break; } }
    }
    nloc = mine > 0u ? mine : 1u; nx = cnt > 0u ? cnt : 1u;
}

__device__ __forceinline__ void xcd_barrier(const XcdBarrier& b) {
    asm volatile("s_waitcnt vmcnt(0)" ::: "memory");
    __syncthreads();
    if (threadIdx.x == 0) {
        unsigned* bar = b.bar;
        __builtin_amdgcn_s_waitcnt(0);
        unsigned nloc = b.st[0], nx = b.st[1];
        if (nloc == 0u) { xcd_barrier_complete(bar, b.x, nloc, nx); b.st[0] = nloc; b.st[1] = nx; }
        const unsigned old = xb_add(&bar[XB_XSUB(b.x)], 1u);
        const unsigned gen = old / nloc;
        if (old + 1u == (gen + 1u) * nloc) {
            __builtin_amdgcn_fence(__ATOMIC_RELEASE, "agent");
            asm volatile("s_waitcnt vmcnt(0)" ::: "memory");
            const unsigned og = xb_add(&bar[XB_TOP], 1u);
            const unsigned tg = og / nx;
            if (og + 1u == (tg + 1u) * nx) xb_add(&bar[XB_TOPGEN], 1u);
            else XB_SPIN(xb_ld(&bar[XB_TOPGEN]) == tg, bar);
            __builtin_amdgcn_fence(__ATOMIC_ACQUIRE, "agent");
            xb_add(&bar[XB_XGEN(b.x)], 1u);
            asm volatile("s_waitcnt vmcnt(0)" ::: "memory");
        } else {
            XB_SPIN(xb_ld(&bar[XB_XGEN(b.x)]) == gen, bar);
            __builtin_amdgcn_fence(__ATOMIC_ACQUIRE, "agent");
            asm volatile("s_waitcnt vmcnt(0)" ::: "memory");
        }
    }
    __syncthreads();
}

struct Args { const float* in[23]; float* out; unsigned char* ws; int ph_lo, ph_hi; };
constexpr int N_PHASES = 2 + 5 * NLAYER;

__global__ void __launch_bounds__(NTHREADS, 2) fwd_megakernel(Args a) {
    extern __shared__ __attribute__((aligned(16))) unsigned char lds_raw[];
    Ctx X0;
    X0.lds = (LAS unsigned char*)lds_raw;
    X0.lane = threadIdx.x & 63; X0.wave = __builtin_amdgcn_readfirstlane(threadIdx.x >> 6);
    X0.gw = blockIdx.x * NWAVES + X0.wave; X0.ngw = gridDim.x * NWAVES;
    X0.out = a.out; X0.ws = a.ws;
    if (threadIdx.x < 23) *(LAS unsigned long long*)(X0.lds + PTR_OFF + 8 * threadIdx.x) = (unsigned long long)a.in[threadIdx.x];
    if (threadIdx.x == 0) { *(volatile LAS unsigned*)(X0.lds + XB_LDS_OFF) = 0u; *(volatile LAS unsigned*)(X0.lds + XB_LDS_OFF + 4) = 0u; }
    LDS_FENCE(); __syncthreads();
    XcdBarrier xbar = xcd_barrier_post((unsigned*)(a.ws + WS_XBAR), (volatile LAS unsigned*)(X0.lds + XB_LDS_OFF));

    for (int ph = a.ph_lo; ph < a.ph_hi; ++ph) {
        if (ph > a.ph_lo) {
            if (ph == a.ph_lo + 1) {
                asm volatile("s_waitcnt vmcnt(0) lgkmcnt(0)" ::: "memory");
                __builtin_amdgcn_fence(__ATOMIC_RELEASE, "agent");
                asm volatile("s_waitcnt vmcnt(0)" ::: "memory");
                __syncthreads();
                cg::this_grid().sync();
                __builtin_amdgcn_fence(__ATOMIC_ACQUIRE, "agent");
                asm volatile("s_waitcnt vmcnt(0)" ::: "memory");
                __syncthreads();
            } else {
                asm volatile("s_waitcnt vmcnt(0) lgkmcnt(0)" ::: "memory");
                xcd_barrier(xbar);
            }
        } else { __builtin_amdgcn_fence(__ATOMIC_ACQUIRE, "agent"); asm volatile("s_waitcnt vmcnt(0)" ::: "memory"); __syncthreads(); }
        Ctx X = X0;
        asm volatile("" : "+v"(X.lane), "+s"(X.wave), "+s"(X.gw), "+s"(X.ngw));
        if (ph == 100) { for (int i = X.gw * 64 + X.lane; i < MROWS * 512; i += X.ngw * 64) X.out[i] = bf2f(W_Z(X)[(size_t)(i >> 9) * DIN + C_UC + (i & 511)]); }
        else if (ph == 101) { for (int i = X.gw * 64 + X.lane; i < 2 * 128 * 32 * 64 * 2; i += X.ngw * 64) X.out[8 * 1024 * 1024 + i] = ((const float*)W_E(X))[i]; }
        else if (ph == 0) phase_prologue(X);
        else if (ph == N_PHASES - 1) phase_final(X);
        else {
            const int l = (ph - 1) / 5, k = (ph - 1) % 5;
            if (k == 0) {
                pg8::Gemm g{W_XB(X), W_WIT(X) + (size_t)l * DIN * DM, MROWS, DIN, DM}; pg8::StaticOrder S; S.init(MROWS, DIN, (int)gridDim.x, (int)blockIdx.x);
                pg8::EpiIn E{X.ws, X.out, l};
                pg8::gemm_phase<pg8::EpiIn, pg8::StaticOrder, true, true>(X.lds, g, S, E);
            } else if (k == 1) phase_mixA(X, l);
            else if (k == 2) {
                phase_carry(X, l);
                if (X.ngw == 2048) {
                    if (X.gw < 1984) { attn_item(X, l, X.gw); attn_item(X, l, X.gw + 1984); if (X.gw >= 1000 && X.gw < 1128) attn_item(X, l, 3968 + X.gw - 1000); }
                } else for (int it = X.gw; it < 4096; it += X.ngw) attn_item(X, l, it);
                if (gridDim.x != 256) { for (int it = X.gw; it < 2048; it += X.ngw) chunk_item(X, l, it); }
                if (gridDim.x >= 16 && gridDim.x != 256 && blockIdx.x < gridDim.x - 8 && l + 1 < NLAYER) { asm volatile("s_waitcnt vmcnt(0) lgkmcnt(0)" ::: "memory"); convert_layer_weights(X, l + 1, X.gw, (int)(gridDim.x - 8) * NWAVES); }
                if (gridDim.x >= 16 && blockIdx.x >= gridDim.x - 8) {
                    asm volatile("s_waitcnt vmcnt(0) lgkmcnt(0)" ::: "memory"); __syncthreads();
                    pg8::Gemm g{W_MIX(X), W_WOT(X) + (size_t)l * DM * DM, MROWS, DM, DM}; pg8::SampleOrder S{(int)blockIdx.x, (int)gridDim.x};
                    pg8::EpiOut E{l == 0 ? (const float*)INP(X, I_XP) : (const float*)W_XRES(X), l == 0 ? (const float*)INP(X, I_XS) : (const float*)(W_XRES(X) + (size_t)8192 * DM), X.ws, l};
                    pg8::gemm_phase<pg8::EpiOut, pg8::SampleOrder, true, true>(X.lds, g, S, E);
                }
            }
            else if (k == 3) phase_s5c(X, l, (int)blockIdx.x, 256);
            else {
                pg8::Gemm g{W_MIX(X), W_WOT(X) + (size_t)l * DM * DM, MROWS, DM, DM}; pg8::StaticOrder S; S.init(gridDim.x >= 16 ? MPROMPT : MROWS, DM, (int)gridDim.x, (int)blockIdx.x);
                pg8::EpiOut E{l == 0 ? (const float*)INP(X, I_XP) : (const float*)W_XRES(X), l == 0 ? (const float*)INP(X, I_XS) : (const float*)(W_XRES(X) + (size_t)8192 * DM), X.ws, l};
                pg8::gemm_phase<pg8::EpiOut, pg8::StaticOrder, true, true>(X.lds, g, S, E);
            }
        }
    }
    asm volatile("s_waitcnt vmcnt(0)" ::: "memory"); __builtin_amdgcn_fence(__ATOMIC_RELEASE, "agent"); asm volatile("s_waitcnt vmcnt(0)" ::: "memory");
}

extern "C" void kernel_launch(void* const* d_in, const int* in_sizes, int n_in, void* d_out, int out_size, void* d_ws, size_t ws_size, hipStream_t stream) {
    static int grid = 0;
    if (grid == 0) {
        if (n_in != 23 || (size_t)out_size != OUT_TOTAL || ws_size < WS_END) { fprintf(stderr, "kernel_launch: unexpected shapes (n_in %d, out %d, ws %zu); nothing launched\n", n_in, out_size, ws_size); grid = -1; return; }
        int dev = 0, cus = 0, per_cu = 0;
        if (hipGetDevice(&dev) != hipSuccess || hipDeviceGetAttribute(&cus, hipDeviceAttributeMultiprocessorCount, dev) != hipSuccess) { grid = -1; return; }
        if (hipFuncSetAttribute((const void*)fwd_megakernel, hipFuncAttributeMaxDynamicSharedMemorySize, LDS_BYTES) != hipSuccess) { fprintf(stderr, "kernel_launch: hipFuncSetAttribute failed\n"); grid = -1; return; }
        if (hipOccupancyMaxActiveBlocksPerMultiprocessor(&per_cu, (const void*)fwd_megakernel, NTHREADS, LDS_BYTES) != hipSuccess || per_cu < 1) { fprintf(stderr, "kernel_launch: occupancy query says %d blocks/CU\n", per_cu); per_cu = 1; }
        (void)hipGetLastError();
        grid = cus;
    }
    if (grid < 0) return;
    if (hipMemsetAsync((char*)d_ws + WS_CTL, 0, CTL_ZERO_BYTES, stream) != hipSuccess) { fprintf(stderr, "kernel_launch: memset failed\n"); return; }
    Args a{};
    for (int i = 0; i < 23; ++i) a.in[i] = (const float*)d_in[i];
    a.out = (float*)d_out; a.ws = (unsigned char*)d_ws;
#if N_LAUNCH_MODE == 1
    a.ph_lo = 0; a.ph_hi = N_PHASES;
    void* args[] = {&a};
    hipError_t e = hipLaunchCooperativeKernel((const void*)fwd_megakernel, dim3(grid), dim3(NTHREADS), args, LDS_BYTES, stream);
    if (e != hipSuccess) fprintf(stderr, "kernel_launch: cooperative launch failed: %s (grid %d)\n", hipGetErrorString(e), grid);
#else
#ifndef DBG_MAX_PH
#define DBG_MAX_PH N_PHASES
#endif
    for (int ph = 0; ph < DBG_MAX_PH; ++ph) {
        a.ph_lo = ph; a.ph_hi = ph + 1;
        hipLaunchKernelGGL(fwd_megakernel, dim3(grid), dim3(NTHREADS), LDS_BYTES, stream, a);
    }
#ifdef DBG_DUMP
    a.ph_lo = DBG_DUMP; a.ph_hi = DBG_DUMP + 1; hipLaunchKernelGGL(fwd_megakernel, dim3(grid), dim3(NTHREADS), LDS_BYTES, stream, a);
#endif
#endif
}
```

```cpp
#include <hip/hip_runtime.h>
#include <hip/hip_cooperative_groups.h>
#include <cstdio>
#include <cstdint>
namespace cg = cooperative_groups;

#ifndef N_LAUNCH_MODE
#define N_LAUNCH_MODE 1
#endif

constexpr int DM = 2048, DIN = 5120, MROWS = 8448, MPROMPT = 8192, NLAYER = 4;
constexpr int C_UA = 0, C_VA = 512, C_GA = 1024, C_Q = 1536, C_K = 2560, C_V = 2816, C_GB = 3072, C_UC = 4096, C_GC = 4608;
constexpr size_t OFF_Y = 0, OFF_KP = 17301504, OFF_VP = 17563648, OFF_KS = 17825792, OFF_VS = 18087936,
                 OFF_HRP = 18350080, OFF_HIP = 18366464, OFF_HRS = 18382848, OFF_HIS = 18644992, OFF_VA = 18907136, OUT_TOTAL = 19431424;
constexpr size_t MiB = 1u << 20;
constexpr size_t WS_CTL = 0, CTL_ZERO_BYTES = 1 * MiB, WS_ROWSS = 65536;
constexpr size_t WS_AB = 1 * MiB, WS_AT = WS_AB + 65536, WS_BB = WS_AT + 65536, WS_CC = WS_BB + 524288, WS_ROPE = WS_CC + 524288, WS_WSB = WS_ROPE + 262656 + 1472  ;
constexpr size_t WS_WGT = 4 * MiB, WS_WOT = 6 * MiB, WS_WIT = 38 * MiB, WS_XB = 118 * MiB, WS_XRES = 151 * MiB, WS_Z = 217 * MiB,
                 WS_MIX = 300 * MiB, WS_VT = 333 * MiB, WS_VAT = 337 * MiB, WS_E = 345 * MiB, WS_H0 = 349 * MiB, WS_END = 353 * MiB;
static_assert(WS_WSB + 524288 <= WS_WGT, "tables fit");
static_assert(WS_WSB % 16 == 0, "align");

namespace pg8 {
#define PG8_LAS __attribute__((address_space(3)))
typedef unsigned short bf16_t;
typedef short bf16x8 __attribute__((ext_vector_type(8)));
typedef float f32x4 __attribute__((ext_vector_type(4)));
typedef unsigned u32x4 __attribute__((ext_vector_type(4)));
typedef unsigned u32x2 __attribute__((ext_vector_type(2)));
constexpr int BM = 256, BK = 64, HALF = 128, HTB = HALF * BK * 2  , STAGE_BYTES = 8 * HTB, NXCD = 8, WGM = 8;
__host__ __device__ __forceinline__ int lds_byte(int r, int c) { const int st = (r >> 4) * 2 + (c >> 5), rr = r & 15, cc = c & 31, ob = rr * 64 + cc * 2; return st * 1024 + (ob ^ (((ob >> 9) & 1) << 5)); }
__host__ __device__ __forceinline__ void stage_rc(int b, int& R, int& C) { const int st = b / 1024, sb = b % 1024, swz = sb ^ (((sb >> 9) & 1) << 5); R = (st >> 1) * 16 + swz / 64; C = (st & 1) * 32 + (swz % 64) / 2; }
__host__ __device__ __forceinline__ int perm32(int rho) { const int n = rho >> 4, i = rho & 15; return 8 * (i >> 2) + 4 * n + (i & 3); }

struct Unit { int pm, pn; };
struct Gemm { const bf16_t* A; const bf16_t* Bt; int M, N, K; };

struct StaticOrder {
    int nM, nN, nwg, G, c;
    __host__ __device__ void init(int M, int N, int G_, int c_) { nM = M / BM; nN = N / BM; nwg = nM * nN; G = G_; c = c_; }
    __host__ __device__ bool next(int i, Unit& u) const {
        const long L = (long)i * G + c; if (L >= nwg) return false;
        int wgid = (int)L; { const int q = nwg / NXCD, r = nwg % NXCD, xcd = wgid % NXCD, off = wgid / NXCD; wgid = (xcd < r ? xcd * (q + 1) : r * (q + 1) + (xcd - r) * q) + off; }
        const int nig = WGM * nN, gid = wgid / nig, fm = gid * WGM, gsz = (nM - fm) < WGM ? (nM - fm) : WGM;
        u.pm = fm + ((wgid % nig) % gsz); u.pn = (wgid % nig) / gsz; return true;
    }
    __device__ __forceinline__ void a_ready(const Unit&) const {}
    __device__ __forceinline__ void done(const Unit&) const {}
};

struct SampleOrder {
    int c, G;
    __device__ __forceinline__ bool next(int i, Unit& u) const { if (i != 0 || c < G - 8) return false; u.pm = 32; u.pn = c - (G - 8); return true; }
    __device__ __forceinline__ void a_ready(const Unit&) const {}
    __device__ __forceinline__ void done(const Unit&) const {}
};
typedef __bf16 bf16x2_t __attribute__((ext_vector_type(2)));
typedef float f32x2_t __attribute__((ext_vector_type(2)));
__device__ __forceinline__ unsigned pk2(float lo, float hi) { f32x2_t v = {lo, hi}; bf16x2_t b = __builtin_convertvector(v, bf16x2_t); return __builtin_bit_cast(unsigned, b); }
__device__ __forceinline__ bf16_t f2bf(float f) { return (bf16_t)(pk2(f, 0.f) & 0xffffu); }
__device__ __forceinline__ float bf2f(bf16_t h) { return __uint_as_float(((unsigned)h) << 16); }

struct EpiIn {
    static constexpr bool PERM = true, AFTER_DRAIN = false;
    unsigned char* ws; float* out; int layer;
    __device__ __forceinline__ void operator()(const f32x4 (&acc)[2][2][4][2], const Unit& u, int wr, int wc, int fr_, int fq_) const {
        int lane_ = threadIdx.x & 63; asm volatile("" : "+v"(lane_));
        const int fr = lane_ & 15, fq = lane_ >> 4;
        const int pn = u.pn, pm = u.pm;
        bf16_t* z = (bf16_t*)(ws + WS_Z); const unsigned long long* rowss = (const unsigned long long*)(ws + WS_ROWSS) + layer * MROWS; const float2* rope = (const float2*)(ws + WS_ROPE);
        bf16_t* vT = (bf16_t*)(ws + WS_VT); bf16_t* vaT = (bf16_t*)(ws + WS_VAT);
        const bool is_rope = (pn >= 6 && pn <= 10) && ((wc & 1) == 0);
#pragma unroll
        for (int ai = 0; ai < 2; ++ai)
#pragma unroll
            for (int m = 0; m < 4; ++m) {
                const int r = pm * BM + ai * HALF + wr * 64 + m * 16 + fr;
                const float rs = rsqrtf((float)rowss[r] * (2.3283064365386963e-10f / 2048.0f) + 1e-5f);
                const int pi = (r < 8192) ? (r & 4095) : (4096 + ((r - 8192) & 7));
#pragma unroll
                for (int bj = 0; bj < 2; ++bj) {
                    f32x4 v0 = acc[ai][bj][m][0] * rs, v1 = acc[ai][bj][m][1] * rs;
                    const int c = pn * BM + bj * HALF + wc * 32 + 8 * fq;
                    if (is_rope) {
                        f32x4 p0, p1;
#pragma unroll
                        for (int e = 0; e < 4; ++e) { p0[e] = __shfl_xor(v0[e], 16); p1[e] = __shfl_xor(v1[e], 16); }
                        if (fq < 2) {
                            const float2* cs = rope + (size_t)pi * 8;
                            const float sg = (fq == 0) ? -1.0f : 1.0f;
#pragma unroll
                            for (int e = 0; e < 4; ++e) {
                                const float2 c0 = cs[e], c1 = cs[4 + e];
                                v0[e] = v0[e] * c0.x + sg * p0[e] * c0.y;
                                v1[e] = v1[e] * c1.x + sg * p1[e] * c1.y;
                            }
                        }
                    }
                    u32x4 w; w.x = pk2(v0[0], v0[1]); w.y = pk2(v0[2], v0[3]); w.z = pk2(v1[0], v1[1]); w.w = pk2(v1[2], v1[3]);
                    *(u32x4*)(z + (size_t)r * DIN + c) = w;
                    if (pn == 10 || pn == 11) {
                        const int cc = c - pn * BM;
                        float* o = nullptr;
                        if (pm == 32) o = out + (pn == 10 ? OFF_KS : OFF_VS) + ((size_t)(layer * 256 + (r - 8192))) * 256 + cc;
                        else if ((pm & 15) == 15 && ai == 1) o = out + (pn == 10 ? OFF_KP : OFF_VP) + ((size_t)((layer * 2 + (pm >> 4)) * 128 + ((r & 4095) - 3968))) * 256 + cc;
                        if (o) { *(f32x4*)o = v0; *(f32x4*)(o + 4) = v1; }
                        if (pn == 11 && pm < 32) {
                            const int b = r >> 12, t = r & 4095;
                            bf16_t* vp = vT + ((size_t)(b * 256 + cc)) * 4096 + t;
#pragma unroll
                            for (int e = 0; e < 8; ++e) vp[(size_t)e * 4096] = (bf16_t)((w[e >> 1] >> (16 * (e & 1))) & 0xffffu);
                        }
                    }
                    if (pn == 2 || pn == 3) {
                        const int ch = c - C_VA;
                        if (pm < 32) {
                            bf16_t* vp = vaT + (size_t)ch * 8192 + r;
#pragma unroll
                            for (int e = 0; e < 8; ++e) vp[(size_t)e * 8192] = (bf16_t)((w[e >> 1] >> (16 * (e & 1))) & 0xffffu);
                        } else {
                            float* o = out + OFF_VA + ((size_t)(layer * 256 + (r - 8192))) * 512 + ch;
                            *(f32x4*)o = v0; *(f32x4*)(o + 4) = v1;
                        }
                    }
                }
            }
    }
};

struct EpiOut {
    static constexpr bool PERM = false, AFTER_DRAIN = false;
    const float* xp; const float* xs; unsigned char* ws; int layer;
    __device__ __forceinline__ void operator()(const f32x4 (&acc)[2][2][4][2], const Unit& u, int wr, int wc, int fr_, int fq_) const {
        int lane_ = threadIdx.x & 63; asm volatile("" : "+v"(lane_));
        const int fr = lane_ & 15, fq = lane_ >> 4;
        float* xres = (float*)(ws + WS_XRES); bf16_t* xb = (bf16_t*)(ws + WS_XB); unsigned long long* rowss_next = (unsigned long long*)(ws + WS_ROWSS) + (layer + 1) * MROWS;
#pragma unroll
        for (int ai = 0; ai < 2; ++ai)
#pragma unroll
            for (int m = 0; m < 4; ++m) {
                const int r = u.pm * BM + ai * HALF + wr * 64 + m * 16 + fr;
                const float* xo = (r < 8192) ? (xp + (size_t)r * DM) : (xs + (size_t)(r - 8192) * DM);
                float ss = 0.f;
#pragma unroll
                for (int bj = 0; bj < 2; ++bj)
#pragma unroll
                    for (int n = 0; n < 2; ++n) {
                        const int c = u.pn * BM + bj * HALF + wc * 32 + 16 * n + 4 * fq;
                        const f32x4 o = *(const f32x4*)(xo + c) + acc[ai][bj][m][n];
                        *(f32x4*)(xres + (size_t)r * DM + c) = o;
                        u32x2 w; w.x = pk2(o[0], o[1]); w.y = pk2(o[2], o[3]);
                        *(u32x2*)(xb + (size_t)r * DM + c) = w;
                        ss += (o[0] * o[0] + o[1] * o[1]) + (o[2] * o[2] + o[3] * o[3]);
                    }
                ss += __shfl_xor(ss, 16); ss += __shfl_xor(ss, 32);
                if (fq == 0) atomicAdd(rowss_next + r, (unsigned long long)(ss * 4294967296.0f));
                asm volatile("" ::: "memory");
            }
    }
};

template <class Epi, class Sched, bool ALIGN_EPI = false, bool SP2 = false>
__device__ __forceinline__ void gemm_phase(PG8_LAS unsigned char* lds, const Gemm g, const Sched& S, const Epi& E) {
    int tid_ = threadIdx.x; asm volatile("" : "+v"(tid_));
    const int tid = tid_, wid = __builtin_amdgcn_readfirstlane(tid >> 6), lane = tid & 63, wr = wid >> 2, wc = wid & 3, fr = lane & 15, fq = lane >> 4;
    const int K = g.K, nt = K / BK;
    unsigned voffA[2], voffB[2];
#pragma unroll
    for (int i = 0; i < 2; ++i) { int R, C; stage_rc(tid * 16 + i * 8192, R, C); const int Rb = Epi::PERM ? ((R & ~31) + perm32(R & 31)) : R;
        voffA[i] = (unsigned)(R * K + C) * 2u; voffB[i] = (unsigned)(Rb * K + C) * 2u; }
    const size_t kstep = (size_t)(BK * 2);
    const size_t hstep = (size_t)HALF * K * 2;
    const size_t tstep = 2 * hstep;
    const unsigned ldsw = (unsigned)wid * 1024u;
    const int aoff = lds_byte(wr * 64 + fr, fq * 8), boff = lds_byte(wc * 32 + fr, fq * 8);
#define PG8_SA(b, h) (((b) * 2 + (h)) * HTB)
#define PG8_SB(b, h) ((4 + (b) * 2 + (h)) * HTB)
#define PG8_STAGE(bufoff, gbase, voff) do { _Pragma("unroll") for (int _i = 0; _i < 2; ++_i) \
        __builtin_amdgcn_global_load_lds((const unsigned*)((const char*)(gbase) + (voff)[_i]), (PG8_LAS unsigned*)(lds + (bufoff) + ldsw + _i * 8192), 16, 0, 0); } while (0)
#define PG8_LDA(dst, b, h) do { _Pragma("unroll") for (int m = 0; m < 4; ++m) _Pragma("unroll") for (int k = 0; k < 2; ++k) dst[m][k] = *(const PG8_LAS bf16x8*)(lds + PG8_SA(b, h) + aoff + m * 2048 + k * 1024); } while (0)
#define PG8_LDB(dst, b, h) do { _Pragma("unroll") for (int n = 0; n < 2; ++n) _Pragma("unroll") for (int k = 0; k < 2; ++k) dst[n][k] = *(const PG8_LAS bf16x8*)(lds + PG8_SB(b, h) + boff + n * 2048 + k * 1024); } while (0)
#define PG8_MMA(ai, bj, At, Bt) do { __builtin_amdgcn_s_setprio(1); _Pragma("unroll") for (int m = 0; m < 4; ++m) _Pragma("unroll") for (int n = 0; n < 2; ++n) _Pragma("unroll") for (int k = 0; k < 2; ++k) \
        acc[ai][bj][m][n] = __builtin_amdgcn_mfma_f32_16x16x32_bf16(Bt[n][k], At[m][k], acc[ai][bj][m][n], 0, 0, 0); __builtin_amdgcn_s_setprio(0); } while (0)
#define PG8_WAIT_V(n) asm volatile("s_waitcnt vmcnt(" #n ")" ::: "memory")
#define PG8_WAIT_L(n) asm volatile("s_waitcnt lgkmcnt(" #n ")" ::: "memory")
#define PG8_BAR __builtin_amdgcn_s_barrier()
#define PG8_SCHED __builtin_amdgcn_sched_barrier(0)
    Unit cur, nxt; int ui = 0;
    if (!S.next(0, cur)) return;
    f32x4 acc[2][2][4][2];
#pragma unroll
    for (int a = 0; a < 2; ++a)
#pragma unroll
        for (int b = 0; b < 2; ++b)
#pragma unroll
            for (int m = 0; m < 4; ++m)
#pragma unroll
                for (int n = 0; n < 2; ++n) acc[a][b][m][n] = (f32x4){0.f, 0.f, 0.f, 0.f};
    bf16x8 At[4][2], B0[2][2], B1[2][2];
    const char* cA = (const char*)g.A + (size_t)cur.pm * tstep; const char* cB = (const char*)g.Bt + (size_t)cur.pn * tstep;
    S.a_ready(cur);
    if constexpr (SP2) {
        PG8_STAGE(PG8_SB(0, 0), cB, voffB); PG8_STAGE(PG8_SB(0, 1), cB + hstep, voffB); PG8_STAGE(PG8_SA(0, 0), cA, voffA); PG8_STAGE(PG8_SA(0, 1), cA + hstep, voffA);
        if (wr == 1) PG8_BAR;
        PG8_WAIT_V(2); PG8_BAR;
        PG8_STAGE(PG8_SB(1, 0), cB + kstep, voffB); PG8_STAGE(PG8_SA(1, 0), cA + kstep, voffA); PG8_STAGE(PG8_SB(1, 1), cB + hstep + kstep, voffB);
        PG8_WAIT_V(6); PG8_BAR;
    } else {
        PG8_STAGE(PG8_SB(0, 0), cB, voffB); PG8_STAGE(PG8_SA(0, 0), cA, voffA); PG8_STAGE(PG8_SB(0, 1), cB + hstep, voffB); PG8_STAGE(PG8_SA(0, 1), cA + hstep, voffA);
        if (wr == 1) PG8_BAR;
        PG8_WAIT_V(4); PG8_BAR;
        PG8_STAGE(PG8_SB(1, 0), cB + kstep, voffB); PG8_STAGE(PG8_SA(1, 0), cA + kstep, voffA); PG8_STAGE(PG8_SB(1, 1), cB + hstep + kstep, voffB);
        PG8_WAIT_V(6); PG8_BAR;
    }
    for (;;) {
        const bool has_next = S.next(ui + 1, nxt);
        const char* nA = has_next ? (const char*)g.A + (size_t)nxt.pm * tstep : cA; const char* nB = has_next ? (const char*)g.Bt + (size_t)nxt.pn * tstep : cB;
        for (int t = 0; t < nt; t += 2) {
            const bool last = (t == nt - 2);
            const char* a1 = cA + (size_t)(t + 1) * kstep;
            const char* a2 = last ? nA : cA + (size_t)(t + 2) * kstep; const char* b2 = last ? nB : cB + (size_t)(t + 2) * kstep;
            const char* a3 = a2 + kstep; const char* b3 = b2 + kstep;
            if (last && has_next) S.a_ready(nxt);
            if constexpr (SP2) {
            PG8_LDB(B0, 0, 0); PG8_LDB(B1, 0, 1); PG8_SCHED; PG8_LDA(At, 0, 0); PG8_STAGE(PG8_SA(1, 1), a1 + hstep, voffA);
            PG8_WAIT_V(8); PG8_WAIT_L(0); PG8_BAR; PG8_MMA(0, 0, At, B0); PG8_MMA(0, 1, At, B1); PG8_BAR; PG8_SCHED;
            PG8_LDA(At, 0, 1); PG8_STAGE(PG8_SB(0, 0), b2, voffB); PG8_STAGE(PG8_SB(0, 1), b2 + hstep, voffB); PG8_STAGE(PG8_SA(0, 0), a2, voffA);
            PG8_WAIT_V(8); PG8_WAIT_L(0); PG8_BAR; PG8_MMA(1, 0, At, B0); PG8_MMA(1, 1, At, B1); PG8_BAR; PG8_SCHED;
            PG8_LDB(B0, 1, 0); PG8_LDB(B1, 1, 1); PG8_SCHED; PG8_LDA(At, 1, 0); PG8_STAGE(PG8_SA(0, 1), a2 + hstep, voffA);
            PG8_WAIT_V(8); PG8_WAIT_L(0); PG8_BAR; PG8_MMA(0, 0, At, B0); PG8_MMA(0, 1, At, B1); PG8_BAR; PG8_SCHED;
            PG8_LDA(At, 1, 1); PG8_STAGE(PG8_SB(1, 0), b3, voffB); PG8_STAGE(PG8_SB(1, 1), b3 + hstep, voffB); PG8_STAGE(PG8_SA(1, 0), a3, voffA);
            PG8_WAIT_V(8); PG8_WAIT_L(0); PG8_BAR; PG8_MMA(1, 0, At, B0); PG8_MMA(1, 1, At, B1); PG8_BAR; PG8_SCHED;
            } else {
            PG8_LDB(B0, 0, 0); PG8_SCHED; PG8_LDA(At, 0, 0); PG8_STAGE(PG8_SA(1, 1), a1 + hstep, voffA);
            PG8_WAIT_L(8); PG8_BAR; PG8_WAIT_L(0); PG8_MMA(0, 0, At, B0); PG8_BAR; PG8_SCHED;
            PG8_LDB(B1, 0, 1); PG8_STAGE(PG8_SB(0, 0), b2, voffB);
            PG8_BAR; PG8_WAIT_L(0); PG8_MMA(0, 1, At, B1); PG8_BAR;
            PG8_LDA(At, 0, 1); PG8_STAGE(PG8_SA(0, 0), a2, voffA);
            PG8_BAR; PG8_WAIT_L(0); PG8_MMA(1, 0, At, B0); PG8_BAR; PG8_SCHED;
            PG8_STAGE(PG8_SB(0, 1), b2 + hstep, voffB);
            PG8_WAIT_V(6); PG8_BAR; PG8_MMA(1, 1, At, B1); PG8_BAR;
            PG8_LDB(B0, 1, 0); PG8_SCHED; PG8_LDA(At, 1, 0); PG8_STAGE(PG8_SA(0, 1), a2 + hstep, voffA);
            PG8_WAIT_L(8); PG8_BAR; PG8_WAIT_L(0); PG8_MMA(0, 0, At, B0); PG8_BAR; PG8_SCHED;
            PG8_LDB(B1, 1, 1); PG8_STAGE(PG8_SB(1, 0), b3, voffB);
            PG8_BAR; PG8_WAIT_L(0); PG8_MMA(0, 1, At, B1); PG8_BAR;
            PG8_LDA(At, 1, 1); PG8_STAGE(PG8_SA(1, 0), a3, voffA);
            PG8_BAR; PG8_WAIT_L(0); PG8_MMA(1, 0, At, B0); PG8_BAR; PG8_SCHED;
            PG8_STAGE(PG8_SB(1, 1), b3 + hstep, voffB);
            PG8_WAIT_V(6); PG8_BAR; PG8_MMA(1, 1, At, B1); PG8_BAR;
            }
        }
        if constexpr (ALIGN_EPI) { if (wr == 0) PG8_BAR; }
        if constexpr (!Epi::AFTER_DRAIN) { E(acc, cur, wr, wc, fr, fq); S.done(cur); }
        if (!has_next) break;
#pragma unroll
        for (int a = 0; a < 2; ++a)
#pragma unroll
            for (int b = 0; b < 2; ++b)
#pragma unroll
                for (int m = 0; m < 4; ++m)
#pragma unroll
                    for (int n = 0; n < 2; ++n) acc[a][b][m][n] = (f32x4){0.f, 0.f, 0.f, 0.f};
        cur = nxt; cA = nA; cB = nB; ++ui;
        if constexpr (ALIGN_EPI) { if (wr == 1) PG8_BAR; }
    }
    PG8_WAIT_V(0);
    if constexpr (!ALIGN_EPI) { if (wr == 0) PG8_BAR; }
    PG8_BAR;
    if constexpr (Epi::AFTER_DRAIN) { E.fused(acc, cur, wr, wc, fr, fq, lds, wid, lane); S.done(cur); }
#undef PG8_SA
#undef PG8_SB
#undef PG8_STAGE
#undef PG8_LDA
#undef PG8_LDB
#undef PG8_MMA
#undef PG8_WAIT_V
#undef PG8_WAIT_L
#undef PG8_BAR
#undef PG8_SCHED
}
}

using pg8::bf16_t; using pg8::bf16x8; using pg8::f32x4; using pg8::u32x4; using pg8::u32x2; using pg8::pk2; using pg8::f2bf; using pg8::bf2f;
#define LAS __attribute__((address_space(3)))
typedef short s16x4 __attribute__((ext_vector_type(4)));
typedef float f32x16 __attribute__((ext_vector_type(16)));
#define MFMA32(a, b, c) __builtin_amdgcn_mfma_f32_32x32x16_bf16((a), (b), (c), 0, 0, 0)
#define MFMA16(a, b, c) __builtin_amdgcn_mfma_f32_16x16x32_bf16((a), (b), (c), 0, 0, 0)
#define LDS_FENCE() asm volatile("s_waitcnt lgkmcnt(0)" ::: "memory")
#define DI __device__ __forceinline__
constexpr int NWAVES = 8, NTHREADS = 512;
constexpr int LDS_BYTES = 147456;
constexpr int WSCR = 8448;
constexpr int YG_OFF = NWAVES * WSCR;
constexpr int YG_LD = 520;

DI int crow(int reg, int h) { return (reg & 3) + 8 * (reg >> 2) + 4 * h; }
DI float sigmoidf_(float x) { return 1.0f / (1.0f + __expf(-x)); }
DI float siluf_(float x) { return x * sigmoidf_(x); }
DI float gelu_tanh(float y) { const float t = 0.7978845608028654f * (y + 0.044715f * y * y * y); const float th = 1.0f - 2.0f / (__expf(2.0f * t) + 1.0f); return 0.5f * y * (1.0f + th); }
DI float wave_sum(float v) {
#pragma unroll
    for (int o = 1; o < 64; o <<= 1) v += __shfl_xor(v, o);
    return v;
}
DI float wave_max(float v) {
#pragma unroll
    for (int o = 1; o < 64; o <<= 1) v = fmaxf(v, __shfl_xor(v, o));
    return v;
}
DI void sincos_d(double ang, float& s, float& c) {
    const double TWO_PI = 6.283185307179586476925, INV_TWO_PI = 0.15915494309189533576888;
    const double k = rint(ang * INV_TWO_PI);
    const double r = ang - k * TWO_PI, r2 = r * r;
    double ss = 1.0, cc = 1.0;
#pragma unroll
    for (int n = 15; n >= 1; --n) { ss = 1.0 - ss * r2 * (1.0 / ((2.0 * n) * (2.0 * n + 1.0))); cc = 1.0 - cc * r2 * (1.0 / ((2.0 * n - 1.0) * (2.0 * n))); }
    s = (float)(r * ss); c = (float)cc;
}

constexpr int PTR_OFF = 140 * 1024, XB_LDS_OFF = 140 * 1024 + 512;
constexpr size_t WS_XBAR = 512 * 1024;
struct Ctx { unsigned char* ws; float* out; LAS unsigned char* lds; int lane, wave, gw, ngw; };
#define GAS __attribute__((address_space(1)))
DI const GAS float* INP(const Ctx& X, int i) { const volatile LAS unsigned* p = (const volatile LAS unsigned*)(X.lds + PTR_OFF + 8 * i);
    const unsigned lo = __builtin_amdgcn_readfirstlane(p[0]), hi = __builtin_amdgcn_readfirstlane(p[1]); return (const GAS float*)(((unsigned long long)hi << 32) | lo); }
#define W_ROWSS(X) ((unsigned long long*)((X).ws + WS_ROWSS))
#define W_AB(X)    ((float2*)((X).ws + WS_AB))
#define W_AT(X)    ((float2*)((X).ws + WS_AT))
#define W_BB(X)    ((bf16_t*)((X).ws + WS_BB))
#define W_CC(X)    ((bf16_t*)((X).ws + WS_CC))
#define W_ROPE(X)  ((float2*)((X).ws + WS_ROPE))
#define W_WSB(X)   ((bf16_t*)((X).ws + WS_WSB))
#define W_WGT(X)   ((bf16_t*)((X).ws + WS_WGT))
#define W_WOT(X)   ((bf16_t*)((X).ws + WS_WOT))
#define W_WIT(X)   ((bf16_t*)((X).ws + WS_WIT))
#define W_XB(X)    ((bf16_t*)((X).ws + WS_XB))
#define W_XRES(X)  ((float*)((X).ws + WS_XRES))
#define W_Z(X)     ((bf16_t*)((X).ws + WS_Z))
#define W_MIX(X)   ((bf16_t*)((X).ws + WS_MIX))
#define W_VT(X)    ((bf16_t*)((X).ws + WS_VT))
#define W_VAT(X)   ((bf16_t*)((X).ws + WS_VAT))
#define W_E(X)     ((float2*)((X).ws + WS_E))
#define W_H0(X)    ((float2*)((X).ws + WS_H0))
enum { I_XP = 0, I_XS, I_CK, I_CV, I_SRE, I_SIM, I_NG, I_FG, I_WIN, I_WOUT, I_CW, I_CB, I_SINK, I_ARE, I_AIM, I_LDT, I_BRE, I_BIM, I_CRE, I_CIM, I_DSK, I_GW, I_GB };

DI void p0_transpose_item(const GAS float* W, const GAS float* gk, int K, int N, bf16_t* WT, LAS float* scr, int item, int lane) {
    const int nblk = N / 32, kb = item / nblk, nb = item % nblk, k0 = 64 * kb, n0 = 32 * nb;
    const int r8 = lane >> 3, c4 = (lane & 7) * 4;
#pragma unroll
    for (int i = 0; i < 8; ++i) { const int kk = 8 * i + r8; f32x4 v = *(const GAS f32x4*)(W + (size_t)(k0 + kk) * N + n0 + c4); if (gk) v = v * gk[k0 + kk];
        LAS float* d = scr + kk * 33 + c4; d[0] = v[0]; d[1] = v[1]; d[2] = v[2]; d[3] = v[3]; }
    LDS_FENCE();
    const int c = lane & 7;
#pragma unroll
    for (int j = 0; j < 4; ++j) { const int n = (lane >> 3) + 8 * j; const LAS float* s = scr + (8 * c) * 33 + n;
        u32x4 o; o.x = pk2(s[0 * 33], s[1 * 33]); o.y = pk2(s[2 * 33], s[3 * 33]); o.z = pk2(s[4 * 33], s[5 * 33]); o.w = pk2(s[6 * 33], s[7 * 33]);
        *(u32x4*)(WT + (size_t)(n0 + n) * K + k0 + 8 * c) = o; }
    LDS_FENCE();
}

DI void convert_layer_weights(const Ctx& X, int l, int w_id, int n_w) {
    LAS float* scr = (LAS float*)(X.lds + X.wave * WSCR);
    constexpr int I_IN = (DM / 64) * (DIN / 32), I_OUT = (DM / 64) * (DM / 32), I_G = (512 / 64) * (512 / 32), I_L = I_IN + I_OUT + I_G;
    const GAS float* w_in = INP(X, I_WIN); const GAS float* w_out = INP(X, I_WOUT); const GAS float* glu_w = INP(X, I_GW); const GAS float* norm_g = INP(X, I_NG);
    for (int it = w_id; it < I_L; it += n_w) {
        int r = it;
        if (r < I_IN) { p0_transpose_item(w_in + (size_t)l * DM * DIN, norm_g + l * DM, DM, DIN, W_WIT(X) + (size_t)l * DIN * DM, scr, r, X.lane); continue; } r -= I_IN;
        if (r < I_OUT) { p0_transpose_item(w_out + (size_t)l * DM * DM, nullptr, DM, DM, W_WOT(X) + (size_t)l * DM * DM, scr, r, X.lane); continue; } r -= I_OUT;
        p0_transpose_item(glu_w + (size_t)l * 512 * 512, nullptr, 512, 512, W_WGT(X) + (size_t)l * 512 * 512, scr, r, X.lane);
    }
}

DI void phase_prologue(const Ctx& X) {
    convert_layer_weights(X, 0, X.gw, X.ngw);
    if (gridDim.x < 16) { for (int l = 1; l < NLAYER; ++l) convert_layer_weights(X, l, X.gw, X.ngw); }
    { const GAS float* x_prompt = INP(X, I_XP); const GAS float* x_sample = INP(X, I_XS);
    for (int m = X.gw; m < MROWS; m += X.ngw) {
        const GAS float* xr = (m < 8192) ? (x_prompt + (size_t)m * DM) : (x_sample + (size_t)(m - 8192) * DM);
        float ss = 0.f;
#pragma unroll
        for (int j = 0; j < 8; ++j) { const f32x4 v = *(const GAS f32x4*)(xr + 4 * X.lane + 256 * j); ss += (v[0] * v[0] + v[1] * v[1]) + (v[2] * v[2] + v[3] * v[3]);
            u32x2 w; w.x = pk2(v[0], v[1]); w.y = pk2(v[2], v[3]); *(u32x2*)(W_XB(X) + (size_t)m * DM + 4 * X.lane + 256 * j) = w; }
        ss = wave_sum(ss);
        if (X.lane == 0) W_ROWSS(X)[m] = (unsigned long long)(ss * 4294967296.0f);
    } }
    const int gt = X.gw * 64 + X.lane, ngt = X.ngw * 64;
    { const GAS float* log_dt = INP(X, I_LDT); const GAS float* a_re = INP(X, I_ARE); const GAS float* a_im = INP(X, I_AIM); const GAS float* b_re = INP(X, I_BRE); const GAS float* b_im = INP(X, I_BIM);
      const GAS float* c_re = INP(X, I_CRE); const GAS float* c_im = INP(X, I_CIM);
    for (int i = gt; i < NLAYER * 32 * 64; i += ngt) {
        const int lg = i >> 6, p = i & 63;
        const float dt = expf(log_dt[lg]); const float ar = a_re[i], ai = a_im[i];
        float sn, cs; sincos_d((double)ai * (double)dt, sn, cs);
        const float mag = expf(ar * dt); const float abr = mag * cs, abi = mag * sn;
        W_AB(X)[i] = make_float2(abr, abi);
        float sn32, cs32; sincos_d((double)ai * (double)dt * 32.0, sn32, cs32);
        const float mag32 = expf(ar * dt * 32.0f);
        W_AT(X)[i] = make_float2(mag32 * cs32, mag32 * sn32);
        const float nr = abr - 1.0f, ni = abi, den = ar * ar + ai * ai;
        const float f_re = (nr * ar + ni * ai) / den, f_im = (ni * ar - nr * ai) / den;
        unsigned wr[8], wi[8];
#pragma unroll
        for (int c2 = 0; c2 < 8; ++c2) {
            const float br0 = b_re[(size_t)i * 16 + 2 * c2], bi0 = b_im[(size_t)i * 16 + 2 * c2], br1 = b_re[(size_t)i * 16 + 2 * c2 + 1], bi1 = b_im[(size_t)i * 16 + 2 * c2 + 1];
            wr[c2] = pk2(f_re * br0 - f_im * bi0, f_re * br1 - f_im * bi1);
            wi[c2] = pk2(f_re * bi0 + f_im * br0, f_re * bi1 + f_im * br1);
        }
        u32x4* rowr = (u32x4*)(W_BB(X) + ((size_t)lg * 128 + p) * 16); u32x4* rowi = (u32x4*)(W_BB(X) + ((size_t)lg * 128 + 64 + p) * 16);
        rowr[0] = (u32x4){wr[0], wr[1], wr[2], wr[3]}; rowr[1] = (u32x4){wr[4], wr[5], wr[6], wr[7]};
        rowi[0] = (u32x4){wi[0], wi[1], wi[2], wi[3]}; rowi[1] = (u32x4){wi[4], wi[5], wi[6], wi[7]};
    }
    for (int j = gt; j < NLAYER * 32 * 16 * 16; j += ngt) {
        const int kc = j & 15, lc = j >> 4, k0 = 8 * kc;
        const GAS float* src = (k0 < 64) ? (c_re + (size_t)lc * 64 + k0) : (c_im + (size_t)lc * 64 + (k0 - 64));
        const float sg = (k0 < 64) ? 1.0f : -1.0f;
        const f32x4 a0 = *(const GAS f32x4*)src, a1 = *(const GAS f32x4*)(src + 4);
        u32x4 w; w.x = pk2(sg * a0[0], sg * a0[1]); w.y = pk2(sg * a0[2], sg * a0[3]); w.z = pk2(sg * a1[0], sg * a1[1]); w.w = pk2(sg * a1[2], sg * a1[3]);
        *(u32x4*)(W_CC(X) + (size_t)lc * 128 + k0) = w;
    } }
    { const GAS float* chunk_w = INP(X, I_CW);
    for (int j = gt; j < NLAYER * 4 * 128 * 16; j += ngt) {
        const int t = (j >> 4) & 127, s0 = (j & 15) * 8;
        const f32x4 a0 = *(const GAS f32x4*)(chunk_w + (size_t)j * 8), a1 = *(const GAS f32x4*)(chunk_w + (size_t)j * 8 + 4);
        float v[8] = {a0[0], a0[1], a0[2], a0[3], a1[0], a1[1], a1[2], a1[3]};
#pragma unroll
        for (int e = 0; e < 8; ++e) v[e] = (s0 + e <= t) ? v[e] : 0.0f;
        u32x4 w; w.x = pk2(v[0], v[1]); w.y = pk2(v[2], v[3]); w.z = pk2(v[4], v[5]); w.w = pk2(v[6], v[7]);
        *(u32x4*)(W_WSB(X) + (size_t)j * 8) = w;
    } }
    for (int i = gt; i < 4104 * 8; i += ngt) {
        const int pi = i >> 3, j = i & 7;
        const double inv[8] = {1.0, 0.19392274474868576, 0.03760603093086393, 0.007292664737217109, 0.001414213562373095, 0.0002742481756762073, 5.318295896944988e-05, 1.031338537721246e-05};
        double iv = inv[0];
#pragma unroll
        for (int q = 1; q < 8; ++q) iv = (j == q) ? inv[q] : iv;
        const double pos = (pi < 4096) ? (double)pi : (double)(16384 + (pi - 4096));
        float sn, cs; sincos_d(pos * iv, sn, cs);
        W_ROPE(X)[i] = make_float2(cs, sn);
    }
}

DI float2 ld_e(const float2* p) { const unsigned long long v = __hip_atomic_load((const unsigned long long*)p, __ATOMIC_RELAXED, __HIP_MEMORY_SCOPE_SYSTEM); float2 r; r.x = __uint_as_float((unsigned)v); r.y = __uint_as_float((unsigned)(v >> 32)); return r; }
template <bool PASS_C>
DI void s5_wave_unit(const Ctx& X, int layer, int u, int slot, LAS float* bu, LAS bf16_t* yg) {
    const int lane = X.lane, r31 = lane & 31, h = lane >> 5;
    const int R0 = 32 * u; const bool samp = (u >= 256);
    const int b = u >> 7, chn = u & 127;
    const GAS float* st_re = INP(X, I_SRE); const GAS float* st_im = INP(X, I_SIM); const GAS float* dskip = INP(X, I_DSK);
    for (int gi = 0; gi < 4; ++gi) {
        const int g = 4 * slot + gi, lg = layer * 32 + g;
        const float2 ab = W_AB(X)[lg * 64 + lane];
        float hr = 0.f, hi = 0.f;
        if (PASS_C && !samp) { const float2 h0 = W_H0(X)[((size_t)(b * 128 + chn) * 32 + g) * 64 + lane]; hr = h0.x; hi = h0.y; }
        bf16x8 ua = *(const bf16x8*)(W_Z(X) + (size_t)(R0 + r31) * DIN + C_UC + 16 * g + 8 * h);
        bf16x8 bbf[4];
#pragma unroll
        for (int nt = 0; nt < 4; ++nt) bbf[nt] = *(const bf16x8*)(W_BB(X) + ((size_t)lg * 128 + 32 * nt + r31) * 16 + 8 * h);
        f32x16 acc[4];
#pragma unroll
        for (int nt = 0; nt < 4; ++nt) {
            f32x16 zz;
#pragma unroll
            for (int i = 0; i < 16; ++i) zz[i] = 0.f;
            asm volatile("" : "+v"(zz));
            acc[nt] = MFMA32(ua, bbf[nt], zz);
        }
        __builtin_amdgcn_sched_barrier(0);
        asm volatile("s_nop 15\n\ts_nop 15\n\ts_nop 15\n\ts_nop 15\n\ts_nop 15\n\ts_nop 15\n\ts_nop 15\n\ts_nop 15"
                     : "+v"(ua), "+v"(bbf[0]), "+v"(bbf[1]), "+v"(bbf[2]), "+v"(bbf[3]), "+v"(acc[0]), "+v"(acc[1]), "+v"(acc[2]), "+v"(acc[3]) :: "memory");
        __builtin_amdgcn_sched_barrier(0);
        bf16x8 cfrag[4];
        if (PASS_C) {
#pragma unroll
            for (int kk = 0; kk < 4; ++kk) cfrag[kk] = *(const bf16x8*)(W_CC(X) + ((size_t)lg * 16 + (lane & 15)) * 128 + 32 * kk + 8 * (lane >> 4));
        }
        const float dsk = PASS_C ? dskip[layer * 512 + 16 * g + (lane & 15)] : 0.f;
#pragma unroll
        for (int half = 0; half < 2; ++half) {
#pragma unroll
            for (int nt = 0; nt < 4; ++nt)
#pragma unroll
                for (int rr = 0; rr < 8; ++rr) bu[((rr & 3) + 8 * (rr >> 2) + 4 * h) * 132 + 32 * nt + r31] = acc[nt][8 * half + rr];
            LDS_FENCE();
            for (int tl = 0; tl < 16; ++tl) {
                const int t = 16 * half + tl;
                if (samp && (t & 7) == 0) { const size_t si = ((size_t)(layer * 32 + ((R0 - 8192 + t) >> 3)) * 32 + g) * 64 + lane; hr = st_re[si]; hi = st_im[si]; }
                const float br = bu[tl * 132 + lane], bi = bu[tl * 132 + 64 + lane];
                const float nr = ab.x * hr - ab.y * hi + br, ni = ab.x * hi + ab.y * hr + bi; hr = nr; hi = ni;
                if (PASS_C) {
                    LDS_FENCE();
                    LAS bf16_t* hs = (LAS bf16_t*)(bu + tl * 132); hs[lane] = f2bf(hr); hs[64 + lane] = f2bf(hi);
                    if (samp && (t & 7) == 7) { const size_t so = ((size_t)(layer * 32 + ((R0 - 8192 + t) >> 3)) * 32 + g) * 64 + lane; X.out[OFF_HRS + so] = hr; X.out[OFF_HIS + so] = hi; }
                }
            }
            LDS_FENCE();
            if (PASS_C) {
                f32x4 d = {0.f, 0.f, 0.f, 0.f}; asm volatile("" : "+v"(d));
#pragma unroll
                for (int kk = 0; kk < 4; ++kk) { const bf16x8 a = *(const LAS bf16x8*)((const LAS unsigned char*)bu + (lane & 15) * 528 + (32 * kk + 8 * (lane >> 4)) * 2); d = MFMA16(a, cfrag[kk], d); }
                __builtin_amdgcn_sched_barrier(0); asm volatile("s_nop 15\n\ts_nop 15\n\ts_nop 15" ::: "memory"); __builtin_amdgcn_sched_barrier(0);
                const int ch = 16 * g + (lane & 15);
#pragma unroll
                for (int reg = 0; reg < 4; ++reg) { const int t = 16 * half + 4 * (lane >> 4) + reg; const float uval = bf2f(W_Z(X)[(size_t)(R0 + t) * DIN + C_UC + ch]);
                    yg[t * YG_LD + ch] = f2bf(gelu_tanh(d[reg] + dsk * uval)); }
                LDS_FENCE();
            }
        }
        if (!PASS_C) { W_E(X)[((size_t)(b * 128 + chn) * 32 + g) * 64 + lane] = make_float2(hr, hi); }
        else if (!samp && chn == 127) { const size_t so = ((size_t)(layer * 2 + b) * 32 + g) * 64 + lane; X.out[OFF_HRP + so] = hr; X.out[OFF_HIP + so] = hi; }
    }
}

DI void phase_s5c(const Ctx& X, int layer, int u_first, int u_end) {
    LAS float* bu = (LAS float*)(X.lds + X.wave * WSCR);
    LAS bf16_t* yg = (LAS bf16_t*)(X.lds + YG_OFF);
    const int lane = X.lane, r31 = lane & 31, h = lane >> 5;
    const GAS float* glu_b = INP(X, I_GB);
    for (int u = u_first; u < u_end; u += gridDim.x) {
        s5_wave_unit<true>(X, layer, u, X.wave, bu, yg);
        LDS_FENCE(); __syncthreads();
        f32x16 ga[2];
#pragma unroll
        for (int nt = 0; nt < 2; ++nt)
#pragma unroll
            for (int i = 0; i < 16; ++i) ga[nt][i] = 0.f;
        asm volatile("" : "+v"(ga[0]), "+v"(ga[1]));
        const bf16_t* wg = W_WGT(X) + ((size_t)layer * 512 + 64 * X.wave + r31) * 512 + 8 * h;
#pragma unroll 1
        for (int kb = 0; kb < 4; ++kb) {
            bf16x8 af8[8], bf8[8][2];
#pragma unroll
            for (int k8 = 0; k8 < 8; ++k8) { const int ks = 8 * kb + k8; af8[k8] = *(const LAS bf16x8*)(yg + r31 * YG_LD + 16 * ks + 8 * h);
#pragma unroll
                for (int nt = 0; nt < 2; ++nt) bf8[k8][nt] = *(const bf16x8*)(wg + (size_t)nt * 32 * 512 + 16 * ks); }
#pragma unroll
            for (int k8 = 0; k8 < 8; ++k8)
#pragma unroll
                for (int nt = 0; nt < 2; ++nt) ga[nt] = MFMA32(af8[k8], bf8[k8][nt], ga[nt]);
            __builtin_amdgcn_sched_barrier(0); asm volatile("s_nop 15\n\ts_nop 15\n\ts_nop 15\n\ts_nop 15\n\ts_nop 15\n\ts_nop 15" ::: "memory"); __builtin_amdgcn_sched_barrier(0);
        }
        const int R0 = 32 * u;
#pragma unroll
        for (int nt = 0; nt < 2; ++nt) {
            const int n = 64 * X.wave + 32 * nt + r31; const float bg = glu_b[layer * 512 + n];
#pragma unroll
            for (int reg = 0; reg < 16; ++reg) { const int t = crow(reg, h); const size_t row = (size_t)(R0 + t);
                const float gate = sigmoidf_(ga[nt][reg] + bg); const float yv = bf2f(yg[t * YG_LD + n]); const float gc = bf2f(W_Z(X)[row * DIN + C_GC + n]);
                W_MIX(X)[row * DM + 1536 + n] = f2bf(yv * gate * siluf_(gc)); }
        }
        LDS_FENCE(); __syncthreads();
    }
}

DI void attn_item(const Ctx& X, int layer, int it) {
    const int lane = X.lane, r31 = lane & 31, h = lane >> 5;
    const int qt = it & 3, rr = (it >> 2) & 3, g = (it >> 4) & 3, blk = (it >> 6) & 31, b = it >> 11;
    const int head = 4 * g + rr, q0 = blk * 128 + 32 * qt, kbase = q0 - 128;
    const size_t rowb = (size_t)b * 4096;
    bf16x8 qf[4];
#pragma unroll
    for (int ks = 0; ks < 4; ++ks) qf[ks] = *(const bf16x8*)(W_Z(X) + (rowb + q0 + r31) * DIN + C_Q + 64 * head + 16 * ks + 8 * h);
    f32x16 S[5];
#pragma unroll
    for (int kb = 0; kb < 2; ++kb) {
        bf16x8 kf[3][4];
#pragma unroll
        for (int kk = 0; kk < 3; ++kk) { const int kt = 3 * kb + kk; if (kt < 5) {
            int tk = kbase + 32 * kt + r31; tk = tk < 0 ? 0 : tk;
            const bf16_t* kp = W_Z(X) + (rowb + tk) * DIN + C_K + 64 * g + 8 * h;
#pragma unroll
            for (int ks = 0; ks < 4; ++ks) kf[kk][ks] = *(const bf16x8*)(kp + 16 * ks); } }
#pragma unroll
        for (int kk = 0; kk < 3; ++kk) { const int kt = 3 * kb + kk; if (kt < 5) {
            f32x16 s;
#pragma unroll
            for (int i = 0; i < 16; ++i) s[i] = 0.f;
            asm volatile("" : "+v"(s));
#pragma unroll
            for (int ks = 0; ks < 4; ++ks) s = MFMA32(kf[kk][ks], qf[ks], s);
            S[kt] = s; } }
        __builtin_amdgcn_sched_barrier(0);
        asm volatile("s_nop 15\n\ts_nop 15\n\ts_nop 15\n\ts_nop 15\n\ts_nop 15\n\ts_nop 15\n\ts_nop 15\n\ts_nop 15" ::: "memory");
        __builtin_amdgcn_sched_barrier(0);
    }
    const float sink = INP(X, I_SINK)[layer * 16 + head];
    float m = sink;
#pragma unroll
    for (int kt = 0; kt < 5; ++kt)
#pragma unroll
        for (int reg = 0; reg < 16; ++reg) { const int jj = 32 * kt + crow(reg, h), dl = jj - r31; const bool ok = (dl >= 1) && (dl <= 128) && (kbase + jj >= 0);
            const float s = ok ? S[kt][reg] * 0.125f : -1e30f; S[kt][reg] = s; m = fmaxf(m, s); }
    m = fmaxf(m, __shfl_xor(m, 32));
    float sum = 0.f;
#pragma unroll
    for (int kt = 0; kt < 5; ++kt)
#pragma unroll
        for (int reg = 0; reg < 16; ++reg) { const float p = __expf(S[kt][reg] - m); S[kt][reg] = p; sum += p; }
    sum += __shfl_xor(sum, 32); sum += __expf(sink - m);
    const float inv = 1.0f / sum;
    f32x16 O[2];
#pragma unroll
    for (int dt = 0; dt < 2; ++dt)
#pragma unroll
        for (int i = 0; i < 16; ++i) O[dt][i] = 0.f;
    asm volatile("" : "+v"(O[0]), "+v"(O[1]));
#pragma unroll
    for (int kt = 0; kt < 5; ++kt)
#pragma unroll
        for (int s2 = 0; s2 < 2; ++s2) {
            u32x4 pw; pw.x = pk2(S[kt][8 * s2 + 0], S[kt][8 * s2 + 1]); pw.y = pk2(S[kt][8 * s2 + 2], S[kt][8 * s2 + 3]); pw.z = pk2(S[kt][8 * s2 + 4], S[kt][8 * s2 + 5]); pw.w = pk2(S[kt][8 * s2 + 6], S[kt][8 * s2 + 7]);
            const bf16x8 pf = __builtin_bit_cast(bf16x8, pw);
            const int tk = kbase + 32 * kt + 16 * s2 + 4 * h; const int t0 = tk < 0 ? 0 : tk, t1 = (tk + 8) < 0 ? 0 : (tk + 8);
            s16x4 vlo[2], vhi[2];
#pragma unroll
            for (int dt = 0; dt < 2; ++dt) { const bf16_t* vp = W_VT(X) + ((size_t)((b * 4 + g) * 64 + 32 * dt + r31)) * 4096; vlo[dt] = *(const s16x4*)(vp + t0); vhi[dt] = *(const s16x4*)(vp + t1); }
#pragma unroll
            for (int dt = 0; dt < 2; ++dt) {
                const bf16x8 vf = __builtin_shufflevector(vlo[dt], vhi[dt], 0, 1, 2, 3, 4, 5, 6, 7);
                O[dt] = MFMA32(vf, pf, O[dt]);
            }
            __builtin_amdgcn_sched_barrier(0); asm volatile("s_nop 15\n\ts_nop 15\n\ts_nop 15\n\ts_nop 15" ::: "memory"); __builtin_amdgcn_sched_barrier(0);
        }
    const size_t rq = rowb + q0 + r31;
#pragma unroll
    for (int dt = 0; dt < 2; ++dt)
#pragma unroll
        for (int rg = 0; rg < 4; ++rg) {
            const int d0 = 32 * dt + 8 * rg + 4 * h;
            const u32x2 gw2 = *(const u32x2*)(W_Z(X) + rq * DIN + C_GB + 64 * head + d0);
            const float g0 = __uint_as_float(gw2.x << 16), g1 = __uint_as_float(gw2.x & 0xffff0000u), g2 = __uint_as_float(gw2.y << 16), g3 = __uint_as_float(gw2.y & 0xffff0000u);
            u32x2 w; w.x = pk2(O[dt][4 * rg + 0] * inv * siluf_(g0), O[dt][4 * rg + 1] * inv * siluf_(g1)); w.y = pk2(O[dt][4 * rg + 2] * inv * siluf_(g2), O[dt][4 * rg + 3] * inv * siluf_(g3));
            *(u32x2*)(W_MIX(X) + rq * DM + 512 + 64 * head + d0) = w;
        }
}

DI void chunk_item(const Ctx& X, int layer, int it) {
    const int lane = X.lane, r31 = lane & 31, h = lane >> 5;
    const int sub = it & 7, hh = (it >> 3) & 3, chunk = it >> 5, ct = sub & 3, th = sub >> 2;
    const GAS float* chunk_b = INP(X, I_CB);
    const bf16_t* ap = W_VAT(X) + ((size_t)(128 * hh + 32 * ct + r31)) * 8192 + chunk * 128 + 8 * h;
    bf16x8 af[8];
#pragma unroll
    for (int ks = 0; ks < 8; ++ks) af[ks] = *(const bf16x8*)(ap + 16 * ks);
#pragma unroll
    for (int t2 = 0; t2 < 2; ++t2) {
        const int tt = 2 * th + t2, t = 32 * tt + r31;
        const bf16_t* bp = W_WSB(X) + ((size_t)((layer * 4 + hh) * 128 + t)) * 128 + 8 * h;
        bf16x8 bfr[8];
        f32x16 d;
#pragma unroll
        for (int i = 0; i < 16; ++i) d[i] = 0.f;
        asm volatile("" : "+v"(d));
#pragma unroll
        for (int ks = 0; ks < 8; ++ks) bfr[ks] = *(const bf16x8*)(bp + 16 * ks);
#pragma unroll
        for (int ks = 0; ks < 8; ++ks) if (ks < 2 * (tt + 1)) d = MFMA32(af[ks], bfr[ks], d);
        __builtin_amdgcn_sched_barrier(0); asm volatile("s_nop 15\n\ts_nop 15\n\ts_nop 15\n\ts_nop 15\n\ts_nop 15\n\ts_nop 15" ::: "memory"); __builtin_amdgcn_sched_barrier(0);
        const size_t row = (size_t)chunk * 128 + t; const float bs = chunk_b[(layer * 4 + hh) * 128 + t];
#pragma unroll
        for (int rg = 0; rg < 4; ++rg) {
            const int c0 = 128 * hh + 32 * ct + 8 * rg + 4 * h;
            const u32x2 uw = *(const u32x2*)(W_Z(X) + row * DIN + C_UA + c0), gw2 = *(const u32x2*)(W_Z(X) + row * DIN + C_GA + c0);
            const float u0 = __uint_as_float(uw.x << 16), u1 = __uint_as_float(uw.x & 0xffff0000u), u2 = __uint_as_float(uw.y << 16), u3 = __uint_as_float(uw.y & 0xffff0000u);
            const float g0 = __uint_as_float(gw2.x << 16), g1 = __uint_as_float(gw2.x & 0xffff0000u), g2 = __uint_as_float(gw2.y << 16), g3 = __uint_as_float(gw2.y & 0xffff0000u);
            u32x2 w; w.x = pk2(u0 * (d[4 * rg + 0] + bs) * siluf_(g0), u1 * (d[4 * rg + 1] + bs) * siluf_(g1)); w.y = pk2(u2 * (d[4 * rg + 2] + bs) * siluf_(g2), u3 * (d[4 * rg + 3] + bs) * siluf_(g3));
            *(u32x2*)(W_MIX(X) + row * DM + c0) = w;
        }
    }
}

DI void sample_chunk_item(const Ctx& X, int layer, int it) {
    const int lane = X.lane, seq = it >> 2, hh = it & 3;
    const size_t row0 = 8192 + (size_t)seq * 8;
    const GAS float* chunk_b = INP(X, I_CB); const GAS float* chunk_w = INP(X, I_CW);
#pragma unroll
    for (int cpass = 0; cpass < 2; ++cpass) {
        const int ch = 128 * hh + 64 * cpass + lane;
        float va[8];
#pragma unroll
        for (int s = 0; s < 8; ++s) va[s] = bf2f(W_Z(X)[(row0 + s) * DIN + C_VA + ch]);
#pragma unroll
        for (int t = 0; t < 8; ++t) {
            float a = chunk_b[(layer * 4 + hh) * 128 + t];
#pragma unroll
            for (int s = 0; s < 8; ++s) if (s <= t) a += chunk_w[((size_t)((layer * 4 + hh) * 128 + t)) * 128 + s] * va[s];
            const float uu = bf2f(W_Z(X)[(row0 + t) * DIN + C_UA + ch]), gg = bf2f(W_Z(X)[(row0 + t) * DIN + C_GA + ch]);
            W_MIX(X)[(row0 + t) * DM + ch] = f2bf(uu * a * siluf_(gg));
        }
    }
}

DI void sample_attn_item(const Ctx& X, int layer, int it, LAS float* scr) {
    const int lane = X.lane, seq = it >> 4, head = it & 15, g = head >> 2;
    const size_t row0 = 8192 + (size_t)seq * 8;
    LAS float* Q = scr; LAS float* P = scr + 512;
    const bf16_t* z = W_Z(X);
#pragma unroll
    for (int i = 0; i < 8; ++i) Q[i * 64 + lane] = bf2f(z[(row0 + i) * DIN + C_Q + 64 * head + lane]) * 0.125f;
    LDS_FENCE();
    const float sink = INP(X, I_SINK)[layer * 16 + head];
    const GAS float* cache_k = INP(X, I_CK);
#pragma unroll 1
    for (int rd = 0; rd < 3; ++rd) {
        const int j = 64 * rd + lane;
        float kv[64];
        if (rd < 2) {
            const GAS float* kp = cache_k + (((size_t)(layer * 32 + seq) * 128 + j) * 4 + g) * 64;
#pragma unroll
            for (int d4 = 0; d4 < 16; ++d4) { const f32x4 v = *(const GAS f32x4*)(kp + 4 * d4); kv[4 * d4] = v[0]; kv[4 * d4 + 1] = v[1]; kv[4 * d4 + 2] = v[2]; kv[4 * d4 + 3] = v[3]; }
        } else {
            const int jn = (lane < 8) ? lane : 0;
            const bf16_t* kp = z + (row0 + jn) * DIN + C_K + 64 * g;
#pragma unroll
            for (int d8 = 0; d8 < 8; ++d8) { const u32x4 w = *(const u32x4*)(kp + 8 * d8);
#pragma unroll
                for (int e = 0; e < 4; ++e) { kv[8 * d8 + 2 * e] = __uint_as_float(w[e] << 16); kv[8 * d8 + 2 * e + 1] = __uint_as_float(w[e] & 0xffff0000u); } }
        }
#pragma unroll
        for (int i = 0; i < 8; ++i) {
            float a = 0.f;
#pragma unroll
            for (int d4 = 0; d4 < 16; ++d4) { const f32x4 q = *(const LAS f32x4*)(Q + i * 64 + 4 * d4); a += q[0] * kv[4 * d4] + q[1] * kv[4 * d4 + 1] + q[2] * kv[4 * d4 + 2] + q[3] * kv[4 * d4 + 3]; }
            const int dl = j - i; const bool ok = (j < 136) && (dl >= 1) && (dl <= 128);
            if (j < 136) P[j * 8 + i] = ok ? a : -1e30f;
        }
    }
    LDS_FENCE();
    float inv[8];
#pragma unroll
    for (int i = 0; i < 8; ++i) {
        const float s0 = P[lane * 8 + i], s1 = P[(64 + lane) * 8 + i], s2 = (lane < 8) ? P[(128 + lane) * 8 + i] : -1e30f;
        const float m = fmaxf(wave_max(fmaxf(fmaxf(s0, s1), s2)), sink);
        const float p0 = __expf(s0 - m), p1 = __expf(s1 - m), p2 = (lane < 8) ? __expf(s2 - m) : 0.f;
        inv[i] = 1.0f / (wave_sum(p0 + p1 + p2) + __expf(sink - m));
        P[lane * 8 + i] = p0; P[(64 + lane) * 8 + i] = p1; if (lane < 8) P[(128 + lane) * 8 + i] = p2;
    }
    LDS_FENCE();
    float o[8];
#pragma unroll
    for (int i = 0; i < 8; ++i) o[i] = 0.f;
    const GAS float* vp = INP(X, I_CV) + (((size_t)(layer * 32 + seq) * 128) * 4 + g) * 64 + lane;
#pragma unroll 16
    for (int j = 0; j < 128; ++j) { const float v = vp[(size_t)j * 256]; const f32x4 p0 = *(const LAS f32x4*)(P + j * 8), p1 = *(const LAS f32x4*)(P + j * 8 + 4);
        o[0] += p0[0] * v; o[1] += p0[1] * v; o[2] += p0[2] * v; o[3] += p0[3] * v; o[4] += p1[0] * v; o[5] += p1[1] * v; o[6] += p1[2] * v; o[7] += p1[3] * v; }
#pragma unroll
    for (int jn = 0; jn < 8; ++jn) { const float v = bf2f(z[(row0 + jn) * DIN + C_V + 64 * g + lane]); const f32x4 p0 = *(const LAS f32x4*)(P + (128 + jn) * 8), p1 = *(const LAS f32x4*)(P + (128 + jn) * 8 + 4);
        o[0] += p0[0] * v; o[1] += p0[1] * v; o[2] += p0[2] * v; o[3] += p0[3] * v; o[4] += p1[0] * v; o[5] += p1[1] * v; o[6] += p1[2] * v; o[7] += p1[3] * v; }
#pragma unroll
    for (int i = 0; i < 8; ++i) { const float gb = bf2f(z[(row0 + i) * DIN + C_GB + 64 * head + lane]); W_MIX(X)[(row0 + i) * DM + 512 + 64 * head + lane] = f2bf(o[i] * inv[i] * siluf_(gb)); }
    LDS_FENCE();
}

DI void phase_mixA(const Ctx& X, int layer) {
    LAS float* scr = (LAS float*)(X.lds + X.wave * WSCR);
    constexpr int N_ATT = 4096, N_CH = 2048, N_SA = 512, N_SC = 128, N_S5 = 2048;
    for (int it = X.gw; it < N_S5; it += X.ngw) s5_wave_unit<false>(X, layer, it >> 3, it & 7, scr, nullptr);
    for (int it = X.gw; it < N_SA; it += X.ngw) sample_attn_item(X, layer, it, scr);
    for (int it = X.gw; it < N_SC; it += X.ngw) sample_chunk_item(X, layer, it);
    if (gridDim.x >= 72 && blockIdx.x >= 64 && blockIdx.x < 72) { asm volatile("s_waitcnt vmcnt(0) lgkmcnt(0)" ::: "memory"); __syncthreads(); phase_s5c(X, layer, 256 + (int)blockIdx.x - 64, 264); }
    else if (gridDim.x < 72) { asm volatile("s_waitcnt vmcnt(0) lgkmcnt(0)" ::: "memory"); __syncthreads(); phase_s5c(X, layer, 256 + (int)blockIdx.x, 264); }
    if (gridDim.x == 256 && blockIdx.x >= 72) {
        for (int it = X.gw - 72 * NWAVES; it < 2048; it += (256 - 72) * NWAVES) chunk_item(X, layer, it);
        if (layer + 1 < NLAYER) { asm volatile("s_waitcnt vmcnt(0) lgkmcnt(0)" ::: "memory"); convert_layer_weights(X, layer + 1, X.gw - 72 * NWAVES, (256 - 72) * NWAVES); }
    }
}

DI void phase_carry(const Ctx& X, int layer) {
    const int lane = X.lane;
    for (int it = X.gw; it < 64; it += X.ngw) {
        const int b = it >> 5, g = it & 31, lg = layer * 32 + g;
        const float2 aT = W_AT(X)[lg * 64 + lane];
        const float2* Ep = W_E(X) + ((size_t)(b * 128) * 32 + g) * 64 + lane;
        float2* Hp = W_H0(X) + ((size_t)(b * 128) * 32 + g) * 64 + lane;
        float hr = 0.f, hi = 0.f;
        for (int c = 0; c < 128; c += 16) {
            float2 e[16];
#pragma unroll
            for (int j = 0; j < 16; ++j) e[j] = Ep[(size_t)(c + j) * 2048];
#pragma unroll
            for (int j = 0; j < 16; ++j) { Hp[(size_t)(c + j) * 2048] = make_float2(hr, hi); const float nr = aT.x * hr - aT.y * hi + e[j].x, ni = aT.x * hi + aT.y * hr + e[j].y; hr = nr; hi = ni; }
        }
    }
}

DI void phase_final(const Ctx& X) {
    const GAS float* final_g = INP(X, I_FG);
    for (int m = X.gw; m < MROWS; m += X.ngw) {
        const float rs = rsqrtf((float)W_ROWSS(X)[4 * MROWS + m] * (2.3283064365386963e-10f / 2048.0f) + 1e-5f);
#pragma unroll
        for (int j = 0; j < 8; ++j) { const int c = 4 * X.lane + 256 * j; const f32x4 v = *(const f32x4*)(W_XRES(X) + (size_t)m * DM + c); const f32x4 gg = *(const GAS f32x4*)(final_g + c);
            __builtin_nontemporal_store(v * rs * gg, (f32x4*)(X.out + OFF_Y + (size_t)m * DM + c)); }
    }
}

#define XB_TMO      128
#define XB_XCNT(j)  (256  + 64 * (j))
#define XB_XSUB(j)  (1280 + 64 * (j))
#define XB_XGEN(j)  (2304 + 64 * (j))
#define XB_TOP      3328
#define XB_TOPGEN   3392
#define XCD_BAR_WORDS 3456
#define XB_SPIN_CAP (1u << 18)

__device__ __forceinline__ unsigned xb_ld(unsigned* p)              { return __hip_atomic_load(p, __ATOMIC_RELAXED, __HIP_MEMORY_SCOPE_AGENT); }
__device__ __forceinline__ unsigned xb_add(unsigned* p, unsigned v) { return __hip_atomic_fetch_add(p, v, __ATOMIC_RELAXED, __HIP_MEMORY_SCOPE_AGENT); }
__device__ __forceinline__ unsigned xb_xcc_id() { return (unsigned)__builtin_amdgcn_s_getreg((3 << 11) | 20) & 0xFu; }
#define XB_SPIN(cond, bar) do { unsigned _sp = 0; while (cond) { __builtin_amdgcn_s_sleep(1); \
    if ((++_sp & 255u) == 0u) { if (xb_ld(&(bar)[XB_TMO])) break; if (_sp > XB_SPIN_CAP) { atomicAdd(&(bar)[XB_TMO], 1u); break; } } } } while (0)

struct XcdBarrier {
    unsigned* bar; unsigned x;
    volatile LAS unsigned* st;
};

__device__ __forceinline__ XcdBarrier xcd_barrier_post(unsigned* bar, volatile LAS unsigned* st) {
    XcdBarrier b; b.bar = bar; b.x = xb_xcc_id(); b.st = st;
    if (threadIdx.x == 0) (void)xb_add(&bar[XB_XCNT(b.x)], 1u);
    return b;
}
__device__ __forceinline__ void xcd_barrier_complete(unsigned* bar, unsigned x, unsigned& nloc, unsigned& nx) {
    const unsigned G = gridDim.x * gridDim.y * gridDim.z;
    unsigned sum, cnt, mine, sp = 0u;
    for (;;) {
        sum = 0u; cnt = 0u; mine = 0u;
#pragma unroll
        for (unsigned j = 0; j < 16; ++j) { const unsigned c = xb_ld(&bar[XB_XCNT(j)]); sum += c; cnt += (c > 0u) ? 1u : 0u; mine = (j == x) ? c : mine; }
        if (sum == G) break;
        __builtin_amdgcn_s_sleep(1);
        if ((++sp & 255u) == 0u) { if (xb_ld(&bar[XB_TMO])) break; if (sp > XB_SPIN_CAP) { atomicAdd(&bar[XB_TMO], 1u); break; } }
    }
    nloc = mine > 0u ? mine : 1u; nx = cnt > 0u ? cnt : 1u;
}

__device__ __forceinline__ void xcd_barrier(const XcdBarrier& b) {
    asm volatile("s_waitcnt vmcnt(0)" ::: "memory");
    __syncthreads();
    if (threadIdx.x == 0) {
        unsigned* bar = b.bar;
        __builtin_amdgcn_s_waitcnt(0);
        unsigned nloc = b.st[0], nx = b.st[1];
        if (nloc == 0u) { xcd_barrier_complete(bar, b.x, nloc, nx); b.st[0] = nloc; b.st[1] = nx; }
        const unsigned old = xb_add(&bar[XB_XSUB(b.x)], 1u);
        const unsigned gen = old / nloc;
        if (old + 1u == (gen + 1u) * nloc) {
            __builtin_amdgcn_fence(__ATOMIC_RELEASE, "agent");
            asm volatile("s_waitcnt vmcnt(0)" ::: "memory");
            const unsigned og = xb_add(&bar[XB_TOP], 1u);
            const unsigned tg = og / nx;
            if (og + 1u == (tg + 1u) * nx) xb_add(&bar[XB_TOPGEN], 1u);
            else XB_SPIN(xb_ld(&bar[XB_TOPGEN]) == tg, bar);
            __builtin_amdgcn_fence(__ATOMIC_ACQUIRE, "agent");
            xb_add(&bar[XB_XGEN(b.x)], 1u);
            asm volatile("s_waitcnt vmcnt(0)" ::: "memory");
        } else {
            XB_SPIN(xb_ld(&bar[XB_XGEN(b.x)]) == gen, bar);
            __builtin_amdgcn_fence(__ATOMIC_ACQUIRE, "agent");
            asm volatile("s_waitcnt vmcnt(0)" ::: "memory");
        }
    }
    __syncthreads();
}

struct Args { const float* in[23]; float* out; unsigned char* ws; int ph_lo, ph_hi; };
constexpr int N_PHASES = 2 + 5 * NLAYER;

__global__ void __launch_bounds__(NTHREADS, 2) fwd_megakernel(Args a) {
    extern __shared__ __attribute__((aligned(16))) unsigned char lds_raw[];
    Ctx X0;
    X0.lds = (LAS unsigned char*)lds_raw;
    X0.lane = threadIdx.x & 63; X0.wave = __builtin_amdgcn_readfirstlane(threadIdx.x >> 6);
    X0.gw = blockIdx.x * NWAVES + X0.wave; X0.ngw = gridDim.x * NWAVES;
    X0.out = a.out; X0.ws = a.ws;
    if (threadIdx.x < 23) *(LAS unsigned long long*)(X0.lds + PTR_OFF + 8 * threadIdx.x) = (unsigned long long)a.in[threadIdx.x];
    if (threadIdx.x == 0) { *(volatile LAS unsigned*)(X0.lds + XB_LDS_OFF) = 0u; *(volatile LAS unsigned*)(X0.lds + XB_LDS_OFF + 4) = 0u; }
    LDS_FENCE(); __syncthreads();
    XcdBarrier xbar = xcd_barrier_post((unsigned*)(a.ws + WS_XBAR), (volatile LAS unsigned*)(X0.lds + XB_LDS_OFF));

    for (int ph = a.ph_lo; ph < a.ph_hi; ++ph) {
        if (ph > a.ph_lo) {
            if (ph == a.ph_lo + 1) {
                asm volatile("s_waitcnt vmcnt(0) lgkmcnt(0)" ::: "memory");
                __builtin_amdgcn_fence(__ATOMIC_RELEASE, "agent");
                asm volatile("s_waitcnt vmcnt(0)" ::: "memory");
                __syncthreads();
                cg::this_grid().sync();
                __builtin_amdgcn_fence(__ATOMIC_ACQUIRE, "agent");
                asm volatile("s_waitcnt vmcnt(0)" ::: "memory");
                __syncthreads();
            } else {
                asm volatile("s_waitcnt vmcnt(0) lgkmcnt(0)" ::: "memory");
                xcd_barrier(xbar);
            }
        } else { __builtin_amdgcn_fence(__ATOMIC_ACQUIRE, "agent"); asm volatile("s_waitcnt vmcnt(0)" ::: "memory"); __syncthreads(); }
        Ctx X = X0;
        asm volatile("" : "+v"(X.lane), "+s"(X.wave), "+s"(X.gw), "+s"(X.ngw));
        if (ph == 100) { for (int i = X.gw * 64 + X.lane; i < MROWS * 512; i += X.ngw * 64) X.out[i] = bf2f(W_Z(X)[(size_t)(i >> 9) * DIN + C_UC + (i & 511)]); }
        else if (ph == 101) { for (int i = X.gw * 64 + X.lane; i < 2 * 128 * 32 * 64 * 2; i += X.ngw * 64) X.out[8 * 1024 * 1024 + i] = ((const float*)W_E(X))[i]; }
        else if (ph == 0) phase_prologue(X);
        else if (ph == N_PHASES - 1) phase_final(X);
        else {
            const int l = (ph - 1) / 5, k = (ph - 1) % 5;
            if (k == 0) {
                pg8::Gemm g{W_XB(X), W_WIT(X) + (size_t)l * DIN * DM, MROWS, DIN, DM}; pg8::StaticOrder S; S.init(MROWS, DIN, (int)gridDim.x, (int)blockIdx.x);
                pg8::EpiIn E{X.ws, X.out, l};
                pg8::gemm_phase<pg8::EpiIn, pg8::StaticOrder, true, true>(X.lds, g, S, E);
            } else if (k == 1) phase_mixA(X, l);
            else if (k == 2) {
                phase_carry(X, l);
                if (X.ngw == 2048) {
                    if (X.gw < 1984) { attn_item(X, l, X.gw); attn_item(X, l, X.gw + 1984); if (X.gw >= 1000 && X.gw < 1128) attn_item(X, l, 3968 + X.gw - 1000); }
                } else for (int it = X.gw; it < 4096; it += X.ngw) attn_item(X, l, it);
                if (gridDim.x != 256) { for (int it = X.gw; it < 2048; it += X.ngw) chunk_item(X, l, it); }
                if (gridDim.x >= 16 && gridDim.x != 256 && blockIdx.x < gridDim.x - 8 && l + 1 < NLAYER) { asm volatile("s_waitcnt vmcnt(0) lgkmcnt(0)" ::: "memory"); convert_layer_weights(X, l + 1, X.gw, (int)(gridDim.x - 8) * NWAVES); }
                if (gridDim.x >= 16 && blockIdx.x >= gridDim.x - 8) {
                    asm volatile("s_waitcnt vmcnt(0) lgkmcnt(0)" ::: "memory"); __syncthreads();
                    pg8::Gemm g{W_MIX(X), W_WOT(X) + (size_t)l * DM * DM, MROWS, DM, DM}; pg8::SampleOrder S{(int)blockIdx.x, (int)gridDim.x};
                    pg8::EpiOut E{l == 0 ? (const float*)INP(X, I_XP) : (const float*)W_XRES(X), l == 0 ? (const float*)INP(X, I_XS) : (const float*)(W_XRES(X) + (size_t)8192 * DM), X.ws, l};
                    pg8::gemm_phase<pg8::EpiOut, pg8::SampleOrder, true, true>(X.lds, g, S, E);
                }
            }
            else if (k == 3) phase_s5c(X, l, (int)blockIdx.x, 256);
            else {
                pg8::Gemm g{W_MIX(X), W_WOT(X) + (size_t)l * DM * DM, MROWS, DM, DM}; pg8::StaticOrder S; S.init(gridDim.x >= 16 ? MPROMPT : MROWS, DM, (int)gridDim.x, (int)blockIdx.x);
                pg8::EpiOut E{l == 0 ? (const float*)INP(X, I_XP) : (const float*)W_XRES(X), l == 0 ? (const float*)INP(X, I_XS) : (const float*)(W_XRES(X) + (size_t)8192 * DM), X.ws, l};
                pg8::gemm_phase<pg8::EpiOut, pg8::StaticOrder, true, true>(X.lds, g, S, E);
            }
        }
    }
    asm volatile("s_waitcnt vmcnt(0)" ::: "memory"); __builtin_amdgcn_fence(__ATOMIC_RELEASE, "agent"); asm volatile("s_waitcnt vmcnt(0)" ::: "memory");
}

extern "C" void kernel_launch(void* const* d_in, const int* in_sizes, int n_in, void* d_out, int out_size, void* d_ws, size_t ws_size, hipStream_t stream) {
    static int grid = 0;
    if (grid == 0) {
        if (n_in != 23 || (size_t)out_size != OUT_TOTAL || ws_size < WS_END) { fprintf(stderr, "kernel_launch: unexpected shapes (n_in %d, out %d, ws %zu); nothing launched\n", n_in, out_size, ws_size); grid = -1; return; }
        int dev = 0, cus = 0, per_cu = 0;
        if (hipGetDevice(&dev) != hipSuccess || hipDeviceGetAttribute(&cus, hipDeviceAttributeMultiprocessorCount, dev) != hipSuccess) { grid = -1; return; }
        if (hipFuncSetAttribute((const void*)fwd_megakernel, hipFuncAttributeMaxDynamicSharedMemorySize, LDS_BYTES) != hipSuccess) { fprintf(stderr, "kernel_launch: hipFuncSetAttribute failed\n"); grid = -1; return; }
        if (hipOccupancyMaxActiveBlocksPerMultiprocessor(&per_cu, (const void*)fwd_megakernel, NTHREADS, LDS_BYTES) != hipSuccess || per_cu < 1) { fprintf(stderr, "kernel_launch: occupancy query says %d blocks/CU\n", per_cu); per_cu = 1; }
        (void)hipGetLastError();
        grid = cus;
    }
    if (grid < 0) return;
    if (hipMemsetAsync((char*)d_ws + WS_CTL, 0, CTL_ZERO_BYTES, stream) != hipSuccess) { fprintf(stderr, "kernel_launch: memset failed\n"); return; }
    Args a{};
    for (int i = 0; i < 23; ++i) a.in[i] = (const float*)d_in[i];
    a.out = (float*)d_out; a.ws = (unsigned char*)d_ws;
#if N_LAUNCH_MODE == 1
    a.ph_lo = 0; a.ph_hi = N_PHASES;
    void* args[] = {&a};
    hipError_t e = hipLaunchCooperativeKernel((const void*)fwd_megakernel, dim3(grid), dim3(NTHREADS), args, LDS_BYTES, stream);
    if (e != hipSuccess) fprintf(stderr, "kernel_launch: cooperative launch failed: %s (grid %d)\n", hipGetErrorString(e), grid);
#else
#ifndef DBG_MAX_PH
#define DBG_MAX_PH N_PHASES
#endif
    for (int ph = 0; ph < DBG_MAX_PH; ++ph) {
        a.ph_lo = ph; a.ph_hi = ph + 1;
        hipLaunchKernelGGL(fwd_megakernel, dim3(grid), dim3(NTHREADS), LDS_BYTES, stream, a);
    }
#ifdef DBG_DUMP
    a.ph_lo = DBG_DUMP; a.ph_hi = DBG_DUMP + 1; hipLaunchKernelGGL(fwd_megakernel, dim3(grid), dim3(NTHREADS), LDS_BYTES, stream, a);
#endif
#endif
}
```
